# Optimizing an MI355X kernel written in HIP

```python
import jax
import jax.numpy as jnp
from jax import lax
import numpy as np

D_MODEL = 2048
BATCH = 1
SEQ = 8192
DEPTH = 2

SB_HEADS = 8
SB_HEAD_DIM = 128
SB_WIDTH = SB_HEADS * SB_HEAD_DIM
SG_GROUPS = 8
SG_GROUP_DIM = 128
SG_WIDTH = SG_GROUPS * SG_GROUP_DIM
CHUNK = 128
Q_BLOCK = 128
N_BRANCH = 2
OFF_Q = 0
OFF_K = OFF_Q + SB_WIDTH
OFF_V = OFF_K + SB_WIDTH
OFF_U = OFF_V + SB_WIDTH
OFF_VG = OFF_U + SG_WIDTH
OFF_GATE = OFF_VG + SG_WIDTH
D_IN = OFF_GATE + N_BRANCH * D_MODEL
D_FF_DENSE = 5504
N_EXPERTS = 8
TOP_K = 2
D_FF_EXPERT = 7168
N_DENSE_LAYERS = (DEPTH + 1) // 2
N_MOE_LAYERS = DEPTH // 2
DEEPNORM_ALPHA = (2.0 * DEPTH) ** 0.25
DEEPNORM_BETA = (8.0 * DEPTH) ** -0.25
LN_EPS = 1e-5

kernel_name = 'hybrid_stickbreak_sgu_moe_deepnorm'


def layer_norm(x, gain, bias):
    xf = x.astype(jnp.float32)
    mu = jnp.mean(xf, axis=-1, keepdims=True)
    var = jnp.mean(jnp.square(xf - mu), axis=-1, keepdims=True)
    y = (xf - mu) * lax.rsqrt(var + LN_EPS) * gain.astype(jnp.float32) + bias.astype(jnp.float32)
    return y.astype(x.dtype)


def stick_breaking_attention(q, k, v):
    B, S, H, Dh = q.shape
    n_blocks = S // Q_BLOCK
    scale = Dh ** -0.5
    key_pos = jnp.arange(S)

    def block(i):
        start = i * Q_BLOCK
        qb = lax.dynamic_slice_in_dim(q, start, Q_BLOCK, axis=1)
        z = jnp.einsum('bqhd,bkhd->bhqk', qb, k,
                       preferred_element_type=jnp.float32) * scale
        q_pos = start + jnp.arange(Q_BLOCK)
        before = key_pos[None, :] < q_pos[:, None]
        log_beta = jax.nn.log_sigmoid(z)
        log_keep = jnp.where(before, jax.nn.log_sigmoid(-z), 0.0)
        tail = lax.cumsum(log_keep, axis=3, reverse=True) - log_keep
        a = jnp.where(before, jnp.exp(log_beta + tail), 0.0)
        return jnp.einsum('bhqk,bkhd->bqhd', a.astype(v.dtype), v)

    out = lax.map(block, jnp.arange(n_blocks))
    return jnp.moveaxis(out, 0, 1).reshape(B, S, H * Dh)


def chunked_spatial_gating(u, v, sg_w, sg_b, ln_g, ln_b):
    B, S, G, Dg = v.shape
    v = layer_norm(v, ln_g.reshape(G, Dg), ln_b.reshape(G, Dg))
    vc = v.reshape(B, S // CHUNK, CHUNK, G, Dg)
    causal = jnp.tril(jnp.ones((CHUNK, CHUNK), dtype=bool))
    w = jnp.where(causal, sg_w, 0.0).astype(v.dtype)
    mixed = jnp.einsum('gts,bcsgd->bctgd', w, vc) + sg_b.T[None, None, :, :, None].astype(v.dtype)
    return (u * mixed.reshape(B, S, G, Dg)).reshape(B, S, G * Dg)


def hybrid_mixer(x, w_in, b_gate, sg_w, sg_b, sg_ln_g, sg_ln_b, w_branch_a, w_branch_b, w_out):
    B, S, D = x.shape
    proj = jnp.einsum('bsd,de->bse', x, w_in)
    q = proj[..., OFF_Q:OFF_K].reshape(B, S, SB_HEADS, SB_HEAD_DIM)
    k = proj[..., OFF_K:OFF_V].reshape(B, S, SB_HEADS, SB_HEAD_DIM)
    v = proj[..., OFF_V:OFF_U].reshape(B, S, SB_HEADS, SB_HEAD_DIM)
    u = jax.nn.gelu(proj[..., OFF_U:OFF_VG]).reshape(B, S, SG_GROUPS, SG_GROUP_DIM)
    vg = jax.nn.gelu(proj[..., OFF_VG:OFF_GATE]).reshape(B, S, SG_GROUPS, SG_GROUP_DIM)
    gates = jax.nn.sigmoid(proj[..., OFF_GATE:].reshape(B, S, N_BRANCH, D)
                           + b_gate.reshape(N_BRANCH, D))
    y_a = stick_breaking_attention(q, k, v) @ w_branch_a
    y_b = chunked_spatial_gating(u, vg, sg_w, sg_b, sg_ln_g, sg_ln_b) @ w_branch_b
    merged = gates[:, :, 0, :] * y_a + gates[:, :, 1, :] * y_b
    return merged @ w_out


def swiglu(x, w1, w3, w2):
    return (jax.nn.silu(x @ w1) * (x @ w3)) @ w2


def moe_swiglu(x, w_router, w1, w3, w2):
    logits = jnp.einsum('bsd,de->bse', x, w_router, preferred_element_type=jnp.float32)
    top_logits, top_idx = lax.top_k(logits, TOP_K)
    top_w = jax.nn.softmax(top_logits, axis=-1)
    combine = jnp.sum(jax.nn.one_hot(top_idx, N_EXPERTS, dtype=jnp.float32)
                      * top_w[..., None], axis=-2)
    y = jnp.zeros_like(x)
    for e in range(N_EXPERTS):
        y = y + combine[..., e:e + 1].astype(x.dtype) * swiglu(x, w1[e], w3[e], w2[e])
    return y


def setup_inputs(seed: int = 0) -> dict:
    key = jax.random.key(seed)
    ks = jax.random.split(key, 32)
    L, D = DEPTH, D_MODEL
    beta = DEEPNORM_BETA

    def nrm(k, shape, scale):
        return jax.random.normal(k, shape, jnp.float32) * scale

    x = nrm(ks[0], (BATCH, SEQ, D), 1.0)
    w_qk = nrm(ks[1], (L, D, 2 * SB_WIDTH), D ** -0.5)
    w_v = nrm(ks[2], (L, D, SB_WIDTH), beta * D ** -0.5)
    w_u = nrm(ks[3], (L, D, SG_WIDTH), beta * D ** -0.5)
    w_vg = nrm(ks[4], (L, D, SG_WIDTH), D ** -0.5)
    w_gt = nrm(ks[5], (L, D, N_BRANCH * D), D ** -0.5)
    w_in = jnp.concatenate([w_qk, w_v, w_u, w_vg, w_gt], axis=-1)
    b_gate = nrm(ks[6], (L, N_BRANCH * D), 0.02)
    sg_w = nrm(ks[7], (L, SG_GROUPS, CHUNK, CHUNK), CHUNK ** -0.5)
    sg_b = 1.0 + nrm(ks[8], (L, SG_GROUPS, CHUNK), 0.02)
    sg_ln_g = 1.0 + nrm(ks[9], (L, SG_WIDTH), 0.02)
    sg_ln_b = nrm(ks[10], (L, SG_WIDTH), 0.02)
    w_branch_a = nrm(ks[11], (L, SB_WIDTH, D), beta * SB_WIDTH ** -0.5)
    w_branch_b = nrm(ks[12], (L, SG_WIDTH, D), beta * SG_WIDTH ** -0.5)
    w_out = nrm(ks[13], (L, D, D), beta * D ** -0.5)
    ln1_g = 1.0 + nrm(ks[14], (L, D), 0.02)
    ln1_b = nrm(ks[15], (L, D), 0.02)
    ffn_w1 = nrm(ks[16], (N_DENSE_LAYERS, D, D_FF_DENSE), beta * D ** -0.5)
    ffn_w3 = nrm(ks[17], (N_DENSE_LAYERS, D, D_FF_DENSE), beta * D ** -0.5)
    ffn_w2 = nrm(ks[18], (N_DENSE_LAYERS, D_FF_DENSE, D), beta * D_FF_DENSE ** -0.5)
    moe_router = nrm(ks[19], (N_MOE_LAYERS, D, N_EXPERTS), D ** -0.5)
    moe_w1 = nrm(ks[20], (N_MOE_LAYERS, N_EXPERTS, D, D_FF_EXPERT), beta * D ** -0.5)
    moe_w3 = nrm(ks[21], (N_MOE_LAYERS, N_EXPERTS, D, D_FF_EXPERT), beta * D ** -0.5)
    moe_w2 = nrm(ks[22], (N_MOE_LAYERS, N_EXPERTS, D_FF_EXPERT, D), beta * D_FF_EXPERT ** -0.5)
    ln2_g = 1.0 + nrm(ks[23], (L, D), 0.02)
    ln2_b = nrm(ks[24], (L, D), 0.02)
    return {'x': x, 'w_in': w_in, 'b_gate': b_gate, 'sg_w': sg_w, 'sg_b': sg_b,
            'sg_ln_g': sg_ln_g, 'sg_ln_b': sg_ln_b, 'w_branch_a': w_branch_a,
            'w_branch_b': w_branch_b, 'w_out': w_out, 'ln1_g': ln1_g, 'ln1_b': ln1_b,
            'ffn_w1': ffn_w1, 'ffn_w3': ffn_w3, 'ffn_w2': ffn_w2, 'moe_router': moe_router,
            'moe_w1': moe_w1, 'moe_w3': moe_w3, 'moe_w2': moe_w2, 'ln2_g': ln2_g, 'ln2_b': ln2_b}


def reference(x, w_in, b_gate, sg_w, sg_b, sg_ln_g, sg_ln_b, w_branch_a, w_branch_b, w_out,
              ln1_g, ln1_b, ffn_w1, ffn_w3, ffn_w2, moe_router, moe_w1, moe_w3, moe_w2,
              ln2_g, ln2_b):
    for layer in range(DEPTH):
        mix = hybrid_mixer(x, w_in[layer], b_gate[layer], sg_w[layer], sg_b[layer],
                           sg_ln_g[layer], sg_ln_b[layer], w_branch_a[layer],
                           w_branch_b[layer], w_out[layer])
        x = layer_norm(DEEPNORM_ALPHA * x + mix, ln1_g[layer], ln1_b[layer])
        i = layer // 2
        if layer % 2 == 0:
            f = swiglu(x, ffn_w1[i], ffn_w3[i], ffn_w2[i])
        else:
            f = moe_swiglu(x, moe_router[i], moe_w1[i], moe_w3[i], moe_w2[i])
        x = layer_norm(DEEPNORM_ALPHA * x + f, ln2_g[layer], ln2_b[layer])
    return x
```

```cpp
#define NEW_MASK 0x3FFFF
#include <hip/hip_runtime.h>
#include <cstdio>
#include <cstdint>

typedef unsigned short bf16;
constexpr int S = 8192, D = 2048, DIN = 9216, SBW = 1024, NH = 8, HD = 128, NG = 8;
constexpr int OFF_Q = 0, OFF_K = 1024, OFF_V = 2048, OFF_U = 3072, OFF_VG = 4096, OFF_GATE = 5120;
constexpr int FF_D = 5504, FF_E = 7168, NE = 8;
constexpr int MAXSLOT = 2 * S + NE * 256;
constexpr float ALPHA = 1.4142135623730951f;
constexpr float LN_EPS = 1e-5f;
constexpr float QSCALE = 0.08838834764831845f * 1.4426950408889634f;

__host__ __device__ __forceinline__ unsigned f2bf_u(float f) { unsigned u = __builtin_bit_cast(unsigned, f); return (u + 0x7fffu + ((u >> 16) & 1u)) >> 16; }
__host__ __device__ __forceinline__ bf16 f2bf(float f) { return (bf16)f2bf_u(f); }
__host__ __device__ __forceinline__ float bf2f(bf16 b) { return __builtin_bit_cast(float, ((unsigned)b) << 16); }
__host__ __device__ __forceinline__ unsigned pk2(float lo, float hi) { return f2bf_u(lo) | (f2bf_u(hi) << 16); }

constexpr size_t MiB = 1u << 20;
constexpr size_t WS_CTL = 0, CTL_ZERO_BYTES = 1 * MiB;
constexpr size_t WS_TINFO = 1 * MiB;
constexpr size_t WS_TW = WS_TINFO + (size_t)S * 16;
constexpr size_t WS_WIN = 2 * MiB;
constexpr size_t WS_WA = WS_WIN + 72 * MiB;
constexpr size_t WS_WB = WS_WA + 8 * MiB;
constexpr size_t WS_WOUT = WS_WB + 8 * MiB;
constexpr size_t WS_W13D = WS_WOUT + 16 * MiB;
constexpr size_t WS_W2D = WS_W13D + 43 * MiB;
constexpr size_t WS_W13E = WS_W2D + 22 * MiB;
constexpr size_t WS_W2E = WS_W13E + 448 * MiB;
constexpr size_t WS_XB = WS_W2E + 224 * MiB;
constexpr size_t WS_XC = WS_XB + 32 * MiB;
constexpr size_t WS_X1 = WS_XC + 64 * MiB;
constexpr size_t WS_X1B = WS_X1 + 64 * MiB;
constexpr size_t WS_Y = WS_X1B + 32 * MiB;
constexpr size_t WS_XG = WS_Y;
constexpr size_t WS_YS = WS_Y + 72 * MiB;
constexpr size_t WS_A = WS_YS + 144 * MiB;
constexpr size_t WS_P = WS_A;
constexpr size_t WS_AO = WS_P + 144 * MiB;
constexpr size_t WS_SO = WS_AO + 16 * MiB;
constexpr size_t WS_T = WS_SO + 16 * MiB;
constexpr size_t WS_MG = WS_T + 64 * MiB;
constexpr size_t WS_H = WS_A;
constexpr size_t WS_END = WS_A + 272 * MiB;
static_assert(WS_MG + 32 * MiB == WS_END && WS_END <= 1792 * MiB, "d_ws map");
constexpr int CW_TMO = 0, CW_CODE = 1;
constexpr int CW_CNT = 64;
constexpr int CW_BAR = 4096;
namespace mk {
#define LAS __attribute__((address_space(3)))
#define GAS __attribute__((address_space(1)))
typedef short bf16x8 __attribute__((ext_vector_type(8)));
typedef short s16x4 __attribute__((ext_vector_type(4)));
typedef float f32x2 __attribute__((ext_vector_type(2)));
typedef float f32x4 __attribute__((ext_vector_type(4)));
typedef float f32x16 __attribute__((ext_vector_type(16)));
typedef unsigned u32x2 __attribute__((ext_vector_type(2)));
typedef unsigned u32x4 __attribute__((ext_vector_type(4)));
typedef GAS unsigned gu32;

constexpr int NWAVES = 8, NTHREADS = 512;
struct Params { const float* in[21]; float* out; unsigned char* ws; int ph_lo, ph_hi, li, sub; };
static_assert(sizeof(Params) == 21 * 8 + 8 + 8 + 16, "Params has no holes");
constexpr int RING_BYTES = 131072;
constexpr int LDSCTL_OFF = RING_BYTES, MISC_OFF = LDSCTL_OFF + 320;
constexpr int LDS_BYTES = 147456;
#define RLX_AGENT __ATOMIC_RELAXED, __HIP_MEMORY_SCOPE_AGENT
#define LDS_WAIT() asm volatile("s_waitcnt lgkmcnt(0)" ::: "memory")
#define VM_WAIT() asm volatile("s_waitcnt vmcnt(0)" ::: "memory")
#define SBAR() __builtin_amdgcn_sched_barrier(0)

__device__ __forceinline__ unsigned cvt_pk_bf16(float lo, float hi) { unsigned r; asm volatile("v_cvt_pk_bf16_f32 %0, %1, %2" : "=v"(r) : "v"(lo), "v"(hi)); return r; }
__device__ __forceinline__ float fast_exp2(float x) { return __builtin_amdgcn_exp2f(x); }
__device__ __forceinline__ float fast_log2(float x) { return __builtin_amdgcn_logf(x); }
__device__ __forceinline__ float fast_rcp(float x) { return __builtin_amdgcn_rcpf(x); }
__device__ __forceinline__ float sigmoid_f(float x) { return fast_rcp(1.f + fast_exp2(-1.4426950408889634f * x)); }
__device__ __forceinline__ float gelu_tanh_f(float x) { const float y2 = 2.f * 0.7978845608028654f * 1.4426950408889634f * (x + 0.044715f * x * x * x); return x * fast_rcp(1.f + fast_exp2(-y2)); }

#define XB_TMO      128
#define XB_XCNT(j)  (256  + 64 * (j))
#define XB_XSUB(j)  (1280 + 64 * (j))
#define XB_XGEN(j)  (2304 + 64 * (j))
#define XB_TOP      3328
#define XB_TOPGEN   3392
#define XCD_BAR_WORDS 3456
#define XB_SPIN_CAP (1u << 22)
__device__ __forceinline__ unsigned xb_ld(unsigned* p)              { return __hip_atomic_load(p, __ATOMIC_RELAXED, __HIP_MEMORY_SCOPE_AGENT); }
__device__ __forceinline__ unsigned xb_add(unsigned* p, unsigned v) { return __hip_atomic_fetch_add(p, v, __ATOMIC_RELAXED, __HIP_MEMORY_SCOPE_AGENT); }
__device__ __forceinline__ unsigned xb_xcc_id() { return (unsigned)__builtin_amdgcn_s_getreg((3 << 11) | 20) & 0xFu; }
#define XB_SPIN(cond, bar) do { unsigned _sp = 0; while (cond) { __builtin_amdgcn_s_sleep(1); \
    if ((++_sp & 255u) == 0u) { if (xb_ld(&(bar)[XB_TMO])) break; if (_sp > XB_SPIN_CAP) { atomicAdd(&(bar)[XB_TMO], 1u); break; } } } } while (0)
struct XcdBarrier { unsigned* bar; unsigned x; volatile LAS unsigned* st; };
__device__ __forceinline__ XcdBarrier xcd_barrier_post(unsigned* bar, volatile LAS unsigned* st) {
    XcdBarrier b; b.bar = bar; b.x = xb_xcc_id(); b.st = st;
    if (threadIdx.x == 0) (void)xb_add(&bar[XB_XCNT(b.x)], 1u);
    return b;
}
__device__ __forceinline__ void xcd_barrier_complete(unsigned* bar, unsigned x, unsigned& nloc, unsigned& nx) {
    const unsigned G = gridDim.x * gridDim.y * gridDim.z;
    unsigned sum, cnt, mine, sp = 0u;
    for (;;) {
        sum = 0u; cnt = 0u; mine = 0u;
#pragma unroll
        for (unsigned j = 0; j < 16; ++j) { const unsigned c = xb_ld(&bar[XB_XCNT(j)]); sum += c; cnt += (c > 0u) ? 1u : 0u; mine = (j == x) ? c : mine; }
        if (sum == G) break;
        __builtin_amdgcn_s_sleep(1);
        if ((++sp & 255u) == 0u) { if (xb_ld(&bar[XB_TMO])) break; if (sp > XB_SPIN_CAP) { atomicAdd(&bar[XB_TMO], 1u); break; } }
    }
    nloc = mine > 0u ? mine : 1u; nx = cnt > 0u ? cnt : 1u;
}
__device__ __forceinline__ void xcd_barrier(const XcdBarrier& b) {
    asm volatile("s_waitcnt vmcnt(0)" ::: "memory");
    __syncthreads();
    if (threadIdx.x == 0) {
        unsigned* bar = b.bar;
        __builtin_amdgcn_s_waitcnt(0);
        unsigned nloc = b.st[0], nx = b.st[1];
        if (nloc == 0u) { xcd_barrier_complete(bar, b.x, nloc, nx); b.st[0] = nloc; b.st[1] = nx; }
        const unsigned old = xb_add(&bar[XB_XSUB(b.x)], 1u);
        const unsigned gen = old / nloc;
        if (old + 1u == (gen + 1u) * nloc) {
            __builtin_amdgcn_fence(__ATOMIC_RELEASE, "agent");
            asm volatile("s_waitcnt vmcnt(0)" ::: "memory");
            const unsigned og = xb_add(&bar[XB_TOP], 1u);
            const unsigned tg = og / nx;
            if (og + 1u == (tg + 1u) * nx) xb_add(&bar[XB_TOPGEN], 1u);
            else XB_SPIN(xb_ld(&bar[XB_TOPGEN]) == tg, bar);
            __builtin_amdgcn_fence(__ATOMIC_ACQUIRE, "agent");
            xb_add(&bar[XB_XGEN(b.x)], 1u);
            asm volatile("s_waitcnt vmcnt(0)" ::: "memory");
        } else {
            XB_SPIN(xb_ld(&bar[XB_XGEN(b.x)]) == gen, bar);
            __builtin_amdgcn_fence(__ATOMIC_ACQUIRE, "agent");
            asm volatile("s_waitcnt vmcnt(0)" ::: "memory");
        }
    }
    __syncthreads();
}

namespace pg8 {
constexpr int BM = 256, BK = 64, HALF = 128, HTB = HALF * BK * 2, STAGE_BYTES = 8 * HTB, NXCD = 8, WGM = 8;
__host__ __device__ __forceinline__ int lds_byte(int r, int c) { const int st = (r >> 4) * 2 + (c >> 5), rr = r & 15, cc = c & 31, ob = rr * 64 + cc * 2; return st * 1024 + (ob ^ (((ob >> 9) & 1) << 5)); }
__host__ __device__ __forceinline__ void stage_rc(int b, int& R, int& C) { const int st = b / 1024, sb = b % 1024, swz = sb ^ (((sb >> 9) & 1) << 5); R = (st >> 1) * 16 + swz / 64; C = (st & 1) * 32 + (swz % 64) / 2; }
__host__ __device__ __forceinline__ int perm32(int rho) { const int n = rho >> 4, i = rho & 15; return 8 * (i >> 2) + 4 * n + (i & 3); }

struct Unit { int pm, pn, kind, aux; const char* a; const char* b0; const char* b1; };
struct TileOrder {
    int nM, nN, nwg, G, c;
    __device__ __forceinline__ void init(int nM_, int nN_, int G_, int c_) { nM = nM_; nN = nN_; nwg = nM * nN; G = G_; c = c_; }
    __device__ __forceinline__ bool map(int i, int& pm, int& pn) const {
        const long L = (long)i * G + c; if (L >= nwg) return false;
        int wgid = (int)L; { const int q = nwg / NXCD, r = nwg % NXCD, xcd = wgid % NXCD, off = wgid / NXCD; wgid = (xcd < r ? xcd * (q + 1) : r * (q + 1) + (xcd - r) * q) + off; }
        const int nig = WGM * nN, gid = wgid / nig, fm = gid * WGM, gsz = (nM - fm) < WGM ? (nM - fm) : WGM;
        pm = fm + ((wgid % nig) % gsz); pn = (wgid % nig) / gsz; return true;
    }
};

template <class Epi, class Sched>
__device__ __forceinline__ void gemm_phase(LAS unsigned char* lds, const int lda, const int ldb, const int K, const Sched& S, const Epi& E) {
    const int tid = threadIdx.x, wid = __builtin_amdgcn_readfirstlane(tid >> 6), lane = tid & 63, wr = wid >> 2, wc = wid & 3, fr = lane & 15, fq = lane >> 4;
    const int nt = K / BK;
    unsigned voffA[2], voffB[2];
#pragma unroll
    for (int i = 0; i < 2; ++i) { int R, C; stage_rc(tid * 16 + i * 8192, R, C); const int Rb = Epi::PERM ? ((R & ~31) + perm32(R & 31)) : R;
        voffA[i] = (unsigned)(R * lda + C) * 2u; voffB[i] = (unsigned)(Rb * ldb + C) * 2u; }
    const size_t kstep = (size_t)(BK * 2);
    const size_t hstepA = (size_t)HALF * lda * 2;
    const unsigned ldsw = (unsigned)wid * 1024u;
    const int aoff = lds_byte(wr * 64 + fr, fq * 8), boff = lds_byte(wc * 32 + fr, fq * 8);
#define PG8_SA(b, h) (((b) * 2 + (h)) * HTB)
#define PG8_SB(b, h) ((4 + (b) * 2 + (h)) * HTB)
#define PG8_STAGE(bufoff, gbase, voff) do { _Pragma("unroll") for (int _i = 0; _i < 2; ++_i) \
        __builtin_amdgcn_global_load_lds((const unsigned*)((const char*)(gbase) + (voff)[_i]), (LAS unsigned*)(lds + (bufoff) + ldsw + _i * 8192), 16, 0, 0); } while (0)
#define PG8_LDA(dst, b, h) do { _Pragma("unroll") for (int m = 0; m < 4; ++m) _Pragma("unroll") for (int k = 0; k < 2; ++k) dst[m][k] = *(const LAS bf16x8*)(lds + PG8_SA(b, h) + aoff + m * 2048 + k * 1024); } while (0)
#define PG8_LDB(dst, b, h) do { _Pragma("unroll") for (int n = 0; n < 2; ++n) _Pragma("unroll") for (int k = 0; k < 2; ++k) dst[n][k] = *(const LAS bf16x8*)(lds + PG8_SB(b, h) + boff + n * 2048 + k * 1024); } while (0)
#define PG8_MMA(ai, bj, At, Bt) do { __builtin_amdgcn_s_setprio(1); _Pragma("unroll") for (int m = 0; m < 4; ++m) _Pragma("unroll") for (int n = 0; n < 2; ++n) _Pragma("unroll") for (int k = 0; k < 2; ++k) \
        acc[ai][bj][m][n] = __builtin_amdgcn_mfma_f32_16x16x32_bf16(Bt[n][k], At[m][k], acc[ai][bj][m][n], 0, 0, 0); __builtin_amdgcn_s_setprio(0); } while (0)
#define PG8_WAIT_V(n) asm volatile("s_waitcnt vmcnt(" #n ")" ::: "memory")
#define PG8_WAIT_L(n) asm volatile("s_waitcnt lgkmcnt(" #n ")" ::: "memory")
#define PG8_BAR __builtin_amdgcn_s_barrier()
#define PG8_SCHED __builtin_amdgcn_sched_barrier(0)
    Unit cur, nxt; int ui = 0;
    if (!S.next(0, cur)) return;
    f32x4 acc[2][2][4][2];
#pragma unroll
    for (int a = 0; a < 2; ++a)
#pragma unroll
        for (int b = 0; b < 2; ++b)
#pragma unroll
            for (int m = 0; m < 4; ++m)
#pragma unroll
                for (int n = 0; n < 2; ++n) acc[a][b][m][n] = (f32x4){0.f, 0.f, 0.f, 0.f};
    bf16x8 At[4][2], B0[2][2], B1[2][2];
    PG8_STAGE(PG8_SB(0, 0), cur.b0, voffB); PG8_STAGE(PG8_SB(0, 1), cur.b1, voffB); PG8_STAGE(PG8_SA(0, 0), cur.a, voffA); PG8_STAGE(PG8_SA(0, 1), cur.a + hstepA, voffA);
    if (wr == 1) PG8_BAR;
    PG8_WAIT_V(2); PG8_BAR;
    PG8_STAGE(PG8_SB(1, 0), cur.b0 + kstep, voffB); PG8_STAGE(PG8_SA(1, 0), cur.a + kstep, voffA); PG8_STAGE(PG8_SB(1, 1), cur.b1 + kstep, voffB);
    PG8_WAIT_V(6); PG8_BAR;
    for (;;) {
        const bool has_next = S.next(ui + 1, nxt);
        const char* nA = has_next ? nxt.a : cur.a; const char* nB0 = has_next ? nxt.b0 : cur.b0; const char* nB1 = has_next ? nxt.b1 : cur.b1;
        for (int t = 0; t < nt; t += 2) {
            const bool last = (t == nt - 2);
            const char* a1 = cur.a + (size_t)(t + 1) * kstep;
            const char* a2 = last ? nA : cur.a + (size_t)(t + 2) * kstep;
            const char* b2_0 = last ? nB0 : cur.b0 + (size_t)(t + 2) * kstep; const char* b2_1 = last ? nB1 : cur.b1 + (size_t)(t + 2) * kstep;
            const char* a3 = a2 + kstep; const char* b3_0 = b2_0 + kstep; const char* b3_1 = b2_1 + kstep;
            PG8_LDB(B0, 0, 0); PG8_LDB(B1, 0, 1); PG8_SCHED; PG8_LDA(At, 0, 0); PG8_STAGE(PG8_SA(1, 1), a1 + hstepA, voffA);
            PG8_WAIT_V(8); PG8_WAIT_L(0); PG8_BAR; PG8_MMA(0, 0, At, B0); PG8_MMA(0, 1, At, B1); PG8_BAR; PG8_SCHED;
            PG8_LDA(At, 0, 1); PG8_STAGE(PG8_SB(0, 0), b2_0, voffB); PG8_STAGE(PG8_SB(0, 1), b2_1, voffB); PG8_STAGE(PG8_SA(0, 0), a2, voffA);
            PG8_WAIT_V(8); PG8_WAIT_L(0); PG8_BAR; PG8_MMA(1, 0, At, B0); PG8_MMA(1, 1, At, B1); PG8_BAR; PG8_SCHED;
            PG8_LDB(B0, 1, 0); PG8_LDB(B1, 1, 1); PG8_SCHED; PG8_LDA(At, 1, 0); PG8_STAGE(PG8_SA(0, 1), a2 + hstepA, voffA);
            PG8_WAIT_V(8); PG8_WAIT_L(0); PG8_BAR; PG8_MMA(0, 0, At, B0); PG8_MMA(0, 1, At, B1); PG8_BAR; PG8_SCHED;
            PG8_LDA(At, 1, 1); PG8_STAGE(PG8_SB(1, 0), b3_0, voffB); PG8_STAGE(PG8_SB(1, 1), b3_1, voffB); PG8_STAGE(PG8_SA(1, 0), a3, voffA);
            PG8_WAIT_V(8); PG8_WAIT_L(0); PG8_BAR; PG8_MMA(1, 0, At, B0); PG8_MMA(1, 1, At, B1); PG8_BAR; PG8_SCHED;
        }
        if (wr == 0) PG8_BAR;
        E(acc, cur, wr, wc, fr, fq);
        if (!has_next) break;
#pragma unroll
        for (int a = 0; a < 2; ++a)
#pragma unroll
            for (int b = 0; b < 2; ++b)
#pragma unroll
                for (int m = 0; m < 4; ++m)
#pragma unroll
                    for (int n = 0; n < 2; ++n) acc[a][b][m][n] = (f32x4){0.f, 0.f, 0.f, 0.f};
        cur = nxt; ++ui;
        if (wr == 1) PG8_BAR;
    }
    PG8_WAIT_V(0);
    PG8_BAR;
#undef PG8_SA
#undef PG8_SB
#undef PG8_STAGE
#undef PG8_LDA
#undef PG8_LDB
#undef PG8_MMA
#undef PG8_WAIT_V
#undef PG8_WAIT_L
#undef PG8_BAR
#undef PG8_SCHED
}
}

namespace pg8 {
struct SchedPlain {
    TileOrder T; const char* A; const char* Bt; size_t tstepA, tstepB, hstepB;
    __device__ __forceinline__ void init(const bf16* A_, int lda, const bf16* Bt_, int ldb, int M, int N, int G, int c) {
        T.init(M / BM, N / BM, G, c); A = (const char*)A_; Bt = (const char*)Bt_; tstepA = (size_t)BM * lda * 2; tstepB = (size_t)BM * ldb * 2; hstepB = (size_t)HALF * ldb * 2; }
    __device__ __forceinline__ bool next(int i, Unit& u) const {
        int pm, pn; if (!T.map(i, pm, pn)) return false;
        u.pm = pm; u.pn = pn; u.kind = 0; u.aux = 0; u.a = A + (size_t)pm * tstepA; u.b0 = Bt + (size_t)pn * tstepB; u.b1 = u.b0 + hstepB; return true; }
};
struct SchedTwoSeg {
    TileOrder T; const char* A0; const char* A1; const char* B0t; const char* B1t; size_t tstepA, tstepB, hstepB;
    __device__ __forceinline__ void init(const bf16* A0_, const bf16* A1_, int lda, const bf16* B0_, const bf16* B1_, int ldb, int M, int N, int G, int c) {
        T.init(M / BM, N / BM, G, c); A0 = (const char*)A0_; A1 = (const char*)A1_; B0t = (const char*)B0_; B1t = (const char*)B1_; tstepA = (size_t)BM * lda * 2; tstepB = (size_t)BM * ldb * 2; hstepB = (size_t)HALF * ldb * 2; }
    __device__ __forceinline__ bool next(int i, Unit& u) const {
        int pm, pn; if (!T.map(i >> 1, pm, pn)) return false;
        const int seg = i & 1; u.pm = pm; u.pn = pn; u.kind = seg; u.aux = 0;
        u.a = (seg ? A1 : A0) + (size_t)pm * tstepA; u.b0 = (seg ? B1t : B0t) + (size_t)pn * tstepB; u.b1 = u.b0 + hstepB; return true; }
};
struct SchedMoe {
    TileOrder T; const char* A; const char* Bt; size_t tstepA, tstepB, hstepB, estepB; const volatile LAS int* pp;
    __device__ __forceinline__ void init(const bf16* A_, int lda, const bf16* Bt_, int ldb, int N, const volatile LAS int* pp_, int G, int c) {
        pp = pp_; const int np = pp[NE]; T.init(np, N / BM, G, c); A = (const char*)A_; Bt = (const char*)Bt_;
        tstepA = (size_t)BM * lda * 2; tstepB = (size_t)BM * ldb * 2; hstepB = (size_t)HALF * ldb * 2; estepB = (size_t)N * ldb * 2; }
    __device__ __forceinline__ bool next(int i, Unit& u) const {
        int pm, pn; if (!T.map(i, pm, pn)) return false;
        int e = 0;
#pragma unroll
        for (int j = 1; j < NE; ++j) e += (pm >= pp[j]) ? 1 : 0;
        u.pm = pm; u.pn = pn; u.kind = 0; u.aux = e; u.a = A + (size_t)pm * tstepA; u.b0 = Bt + (size_t)e * estepB + (size_t)pn * tstepB; u.b1 = u.b0 + hstepB; return true; }
};

typedef const f32x4 (&AccRef)[2][2][4][2];
struct EpiProj {
    static constexpr bool PERM = true;
    bf16* P; const float* bgate;
    __device__ __forceinline__ void operator()(AccRef acc, const Unit& u, int wr, int wc, int fr, int fq) const {
        const int row0 = u.pm * BM + wr * 64 + fr, col0 = u.pn * BM + wc * 32 + 8 * fq;
        const int mode = u.pn < 4 ? 0 : (u.pn < 12 ? 1 : (u.pn < 20 ? 2 : 3));
        f32x4 bv[2][2];
#pragma unroll
        for (int bj = 0; bj < 2; ++bj)
#pragma unroll
            for (int n = 0; n < 2; ++n) bv[bj][n] = (mode == 3) ? *(const f32x4*)(bgate + (col0 - OFF_GATE) + bj * HALF + 4 * n) : (f32x4){0.f, 0.f, 0.f, 0.f};
#pragma unroll
        for (int ai = 0; ai < 2; ++ai)
#pragma unroll
            for (int m = 0; m < 4; ++m) { bf16* rowp = P + (size_t)(row0 + ai * HALF + m * 16) * DIN + col0;
#pragma unroll
                for (int bj = 0; bj < 2; ++bj) { f32x4 v0 = acc[ai][bj][m][0], v1 = acc[ai][bj][m][1];
                    if (mode == 0) { v0 = v0 * QSCALE; v1 = v1 * QSCALE; }
                    else if (mode == 2) {
#pragma unroll
                        for (int j = 0; j < 4; ++j) { v0[j] = gelu_tanh_f(v0[j]); v1[j] = gelu_tanh_f(v1[j]); } }
                    else if (mode == 3) { v0 = v0 + bv[bj][0]; v1 = v1 + bv[bj][1];
#pragma unroll
                        for (int j = 0; j < 4; ++j) { v0[j] = sigmoid_f(v0[j]); v1[j] = sigmoid_f(v1[j]); } }
                    u32x4 w; w.x = cvt_pk_bf16(v0[0], v0[1]); w.y = cvt_pk_bf16(v0[2], v0[3]); w.z = cvt_pk_bf16(v1[0], v1[1]); w.w = cvt_pk_bf16(v1[2], v1[3]);
                    *(u32x4*)(rowp + bj * HALF) = w; } }
    }
};
__device__ __forceinline__ f32x4 bf4_to_f32(u32x2 w) { f32x4 r; r[0] = __builtin_bit_cast(float, w.x << 16); r[1] = __builtin_bit_cast(float, w.x & 0xffff0000u); r[2] = __builtin_bit_cast(float, w.y << 16); r[3] = __builtin_bit_cast(float, w.y & 0xffff0000u); return r; }
struct EpiBranch {
    static constexpr bool PERM = false;
    float* T; bf16* MG; const bf16* P;
    __device__ __forceinline__ void operator()(AccRef acc, const Unit& u, int wr, int wc, int fr, int fq) const {
        const int row0 = u.pm * BM + wr * 64 + fr, col0 = u.pn * BM + wc * 32 + 4 * fq;
        const int goff = OFF_GATE + (u.kind ? D : 0);
#pragma unroll
        for (int ai = 0; ai < 2; ++ai)
#pragma unroll
            for (int m = 0; m < 4; ++m) { const size_t row = (size_t)(row0 + ai * HALF + m * 16);
#pragma unroll
                for (int bj = 0; bj < 2; ++bj)
#pragma unroll
                    for (int n = 0; n < 2; ++n) { const int col = col0 + bj * HALF + n * 16;
                        const f32x4 g = bf4_to_f32(*(const u32x2*)(P + row * DIN + goff + col));
                        if (u.kind == 0) { *(f32x4*)(T + row * D + col) = g * acc[ai][bj][m][n]; }
                        else { const f32x4 t = *(const f32x4*)(T + row * D + col); const f32x4 o = t + g * acc[ai][bj][m][n];
                            u32x2 w; w.x = cvt_pk_bf16(o[0], o[1]); w.y = cvt_pk_bf16(o[2], o[3]); *(u32x2*)(MG + row * D + col) = w; } } }
    }
};
struct EpiResid {
    static constexpr bool PERM = false;
    float* Y; const float* X;
    __device__ __forceinline__ void operator()(AccRef acc, const Unit& u, int wr, int wc, int fr, int fq) const {
        const int row0 = u.pm * BM + wr * 64 + fr, col0 = u.pn * BM + wc * 32 + 4 * fq;
#pragma unroll
        for (int ai = 0; ai < 2; ++ai)
#pragma unroll
            for (int m = 0; m < 4; ++m) { const size_t off = (size_t)(row0 + ai * HALF + m * 16) * D + col0;
#pragma unroll
                for (int bj = 0; bj < 2; ++bj)
#pragma unroll
                    for (int n = 0; n < 2; ++n) { f32x4 o = acc[ai][bj][m][n];
                        if (X) { const f32x4 x = *(const f32x4*)(X + off + bj * HALF + n * 16); o = o + x * ALPHA; }
                        *(f32x4*)(Y + off + bj * HALF + n * 16) = o; } }
    }
};
struct EpiSwiGlu {
    static constexpr bool PERM = true;
    bf16* H; long ldh;
    __device__ __forceinline__ void operator()(AccRef acc, const Unit& u, int wr, int wc, int fr, int fq) const {
        const int row0 = u.pm * BM + wr * 64 + fr, col0 = u.pn * HALF + wc * 32 + 8 * fq;
#pragma unroll
        for (int ai = 0; ai < 2; ++ai)
#pragma unroll
            for (int m = 0; m < 4; ++m) { bf16* rowp = H + (size_t)(row0 + ai * HALF + m * 16) * ldh + col0;
                f32x4 o[2];
#pragma unroll
                for (int n = 0; n < 2; ++n) { const f32x4 a = acc[ai][0][m][n], b = acc[ai][1][m][n];
#pragma unroll
                    for (int j = 0; j < 4; ++j) o[n][j] = a[j] * sigmoid_f(a[j]) * b[j]; }
                u32x4 w; w.x = cvt_pk_bf16(o[0][0], o[0][1]); w.y = cvt_pk_bf16(o[0][2], o[0][3]); w.z = cvt_pk_bf16(o[1][0], o[1][1]); w.w = cvt_pk_bf16(o[1][2], o[1][3]);
                *(u32x4*)rowp = w; }
    }
};
}

struct Frame {
    LAS unsigned char* lds;
    volatile LAS unsigned* MISC;
    gu32* ctl;
    int tid, lane, wave, vcu, G;
};
__device__ __forceinline__ float wave_sum(float v) {
#pragma unroll
    for (int o = 1; o < 64; o <<= 1) v += __shfl_xor(v, o);
    return v;
}
__device__ __forceinline__ void cvt_tile(const float* __restrict__ W, int ldw, bf16* __restrict__ WT, int ldt, int k0, int n0, int rs, int ro, LAS unsigned char* scr, int lane) {
    const int kq = lane & 3, nq = lane >> 2;
    const float* src = W + (size_t)(k0 + kq) * ldw + n0 + 4 * nq;
    f32x4 v[16];
#pragma unroll
    for (int j = 0; j < 16; ++j) v[j] = *(const f32x4*)(src + (size_t)(4 * j) * ldw);
#pragma unroll
    for (int j = 0; j < 16; ++j) {
        const int k = 4 * j + kq;
        const unsigned w01 = cvt_pk_bf16(v[j][0], v[j][1]), w23 = cvt_pk_bf16(v[j][2], v[j][3]);
        const int cb = (((k >> 3) ^ (nq & 7)) << 4) | ((k & 7) << 1);
        LAS unsigned char* p = scr + (4 * nq) * 128 + cb;
        *(LAS unsigned short*)(p) = (unsigned short)(w01 & 0xffffu);
        *(LAS unsigned short*)(p + 128) = (unsigned short)(w01 >> 16);
        *(LAS unsigned short*)(p + 256) = (unsigned short)(w23 & 0xffffu);
        *(LAS unsigned short*)(p + 384) = (unsigned short)(w23 >> 16);
    }
    LDS_WAIT(); asm volatile("" ::: "memory");
    const int c = lane & 7;
#pragma unroll
    for (int r = 0; r < 8; ++r) {
        const int n = (lane >> 3) + 8 * r;
        const u32x4 o = *(const LAS u32x4*)(scr + n * 128 + ((c ^ ((n >> 2) & 7)) << 4));
        const int ng = n0 + n, drow = (ng >> 7) * rs + (ng & 127) + ro;
        *(u32x4*)(WT + (size_t)drow * ldt + k0 + 8 * c) = o;
    }
    LDS_WAIT(); asm volatile("" ::: "memory");
}
struct CvtSeg { const float* W; bf16* WT; int K, N, rs, ro; };
__device__ __forceinline__ void p0_convert(Frame& F, const Params& p) {
    unsigned char* ws = p.ws;
    LAS unsigned char* scr = F.lds + F.wave * 8192;
    const int gw = F.vcu * NWAVES + F.wave, NGW = F.G * NWAVES;
    constexpr int NSEG = 2 + 2 + 2 + 2 + 3 + 3;
    for (int sgi = 0; sgi < NSEG; ++sgi) {
        const float* W; bf16* WT; int K, N, rs = 128, ro = 0, reps = 1; size_t wstep = 0, tstep = 0;
        if (sgi < 2)       { W = p.in[1] + (size_t)sgi * D * DIN; WT = (bf16*)(ws + WS_WIN) + (size_t)sgi * DIN * D; K = D; N = DIN; }
        else if (sgi < 4)  { W = p.in[7] + (size_t)(sgi - 2) * SBW * D; WT = (bf16*)(ws + WS_WA) + (size_t)(sgi - 2) * D * SBW; K = SBW; N = D; }
        else if (sgi < 6)  { W = p.in[8] + (size_t)(sgi - 4) * SBW * D; WT = (bf16*)(ws + WS_WB) + (size_t)(sgi - 4) * D * SBW; K = SBW; N = D; }
        else if (sgi < 8)  { W = p.in[9] + (size_t)(sgi - 6) * D * D; WT = (bf16*)(ws + WS_WOUT) + (size_t)(sgi - 6) * D * D; K = D; N = D; }
        else if (sgi == 8) { W = p.in[12]; WT = (bf16*)(ws + WS_W13D); K = D; N = FF_D; rs = 256; ro = 0; }
        else if (sgi == 9) { W = p.in[13]; WT = (bf16*)(ws + WS_W13D); K = D; N = FF_D; rs = 256; ro = 128; }
        else if (sgi == 10){ W = p.in[14]; WT = (bf16*)(ws + WS_W2D); K = FF_D; N = D; }
        else if (sgi == 11){ W = p.in[16]; WT = (bf16*)(ws + WS_W13E); K = D; N = FF_E; rs = 256; ro = 0; reps = NE; wstep = (size_t)D * FF_E; tstep = (size_t)2 * FF_E * D; }
        else if (sgi == 12){ W = p.in[17]; WT = (bf16*)(ws + WS_W13E); K = D; N = FF_E; rs = 256; ro = 128; reps = NE; wstep = (size_t)D * FF_E; tstep = (size_t)2 * FF_E * D; }
        else               { W = p.in[18]; WT = (bf16*)(ws + WS_W2E); K = FF_E; N = D; reps = NE; wstep = (size_t)FF_E * D; tstep = (size_t)D * FF_E; }
        const int ntn = N / 64, ntk = K / 64, per = ntn * ntk, tot = per * reps;
        for (int it = gw; it < tot; it += NGW) {
            const int rep = it / per, r = it - rep * per, kt = r / ntn, nti = r - kt * ntn;
            cvt_tile(W + (size_t)rep * wstep, N, WT + (size_t)rep * tstep, K, kt * 64, nti * 64, rs, ro, scr, F.lane);
        }
    }
    { const f32x4* x = (const f32x4*)p.in[0]; u32x2* o = (u32x2*)(ws + WS_XB); const size_t n4 = (size_t)S * D / 4;
        for (size_t i = (size_t)blockIdx.x * NTHREADS + F.tid; i < n4; i += (size_t)F.G * NTHREADS) { const f32x4 v = x[i]; u32x2 w; w.x = cvt_pk_bf16(v[0], v[1]); w.y = cvt_pk_bf16(v[2], v[3]); o[i] = w; } }
}

namespace att {
#define KSWZ(row, colB) ((row) * 256 + ((colB) ^ (((row) & 7) << 4)))
__device__ __forceinline__ int crow(int r, int hi) { return (r & 3) + 8 * (r >> 2) + 4 * hi; }
__device__ __forceinline__ int v_st(int k, int c) { const int kk = (k & ~0xC) | ((k & 4) << 1) | ((k & 8) >> 1); return ((kk >> 3) * 4 + (c >> 5)) * 512 + ((kk & 7) * 32 + (c & 31)) * 2; }
__device__ __forceinline__ int v_rd_base(int lane) { return ((lane & 3) << 3) | (((lane >> 2) & 3) << 6) | (((lane >> 4) & 1) << 5) | (((lane >> 5) & 1) << 8); }
constexpr int v_rd_off(int d0, int ks, int half) { return d0 * 512 + ks * 4096 + half * 2048; }
template <int OFF> __device__ __forceinline__ s16x4 tr_read(int vb) {
    s16x4 r; asm volatile("ds_read_b64_tr_b16 %0, %1 offset:%2" : "=&v"(r) : "v"(vb), "i"(OFF) : "memory"); return r;
}
template <int D0> __device__ __forceinline__ void pv_one(f32x16& od, int vb, bf16x8 pa0, bf16x8 pa1, bf16x8 pa2, bf16x8 pa3) {
    const s16x4 l0 = tr_read<v_rd_off(D0, 0, 0)>(vb), h0 = tr_read<v_rd_off(D0, 0, 1)>(vb), l1 = tr_read<v_rd_off(D0, 1, 0)>(vb), h1 = tr_read<v_rd_off(D0, 1, 1)>(vb);
    const s16x4 l2 = tr_read<v_rd_off(D0, 2, 0)>(vb), h2 = tr_read<v_rd_off(D0, 2, 1)>(vb), l3 = tr_read<v_rd_off(D0, 3, 0)>(vb), h3 = tr_read<v_rd_off(D0, 3, 1)>(vb);
    asm volatile("s_waitcnt lgkmcnt(0)" ::: "memory"); SBAR();
#define PK(L, H) (bf16x8){L[0], L[1], L[2], L[3], H[0], H[1], H[2], H[3]}
    od = __builtin_amdgcn_mfma_f32_32x32x16_bf16(pa0, PK(l0, h0), od, 0, 0, 0);
    od = __builtin_amdgcn_mfma_f32_32x32x16_bf16(pa1, PK(l1, h1), od, 0, 0, 0);
    od = __builtin_amdgcn_mfma_f32_32x32x16_bf16(pa2, PK(l2, h2), od, 0, 0, 0);
    od = __builtin_amdgcn_mfma_f32_32x32x16_bf16(pa3, PK(l3, h3), od, 0, 0, 0);
#undef PK
}
__device__ __forceinline__ void qkt(f32x16& p0, f32x16& p1, const LAS unsigned char* Ks, const bf16x8* qr, int r32, int hi) {
    p0 = f32x16{}; p1 = f32x16{};
#pragma unroll
    for (int d0 = 0; d0 < 8; ++d0) { const int cb = (d0 * 16 + hi * 8) * 2;
        const bf16x8 b0 = *(const LAS bf16x8*)(Ks + KSWZ(r32, cb));
        const bf16x8 b1 = *(const LAS bf16x8*)(Ks + KSWZ(32 + r32, cb));
        p0 = __builtin_amdgcn_mfma_f32_32x32x16_bf16(b0, qr[d0], p0, 0, 0, 0);
        p1 = __builtin_amdgcn_mfma_f32_32x32x16_bf16(b1, qr[d0], p1, 0, 0, 0); }
}
__device__ __forceinline__ void stick_tile(f32x16& p0, f32x16& p1, float& Rm, int hi, bf16x8& pa0, bf16x8& pa1, bf16x8& pa2, bf16x8& pa3) {
    float I[8][4];
#pragma unroll
    for (int g = 0; g < 8; ++g) {
#pragma unroll
        for (int e = 3; e >= 0; --e) {
            const float z = (g < 4) ? p0[4 * g + e] : p1[4 * (g - 4) + e];
            const float sp = fast_log2(1.f + fast_exp2(fminf(z, 126.f)));
            I[g][e] = (e == 3) ? sp : I[g][e + 1] + sp;
        }
    }
    float IS[9];
    IS[8] = hi ? 0.f : Rm;
#pragma unroll
    for (int g = 7; g >= 0; --g) IS[g] = IS[g + 1] + I[g][0];
    float TB[8];
#pragma unroll
    for (int g = 0; g < 8; ++g) {
        const auto rr = __builtin_amdgcn_permlane32_swap(__float_as_uint(IS[g]), __float_as_uint(IS[g + 1]), false, false);
        const float sel = hi ? __uint_as_float(rr[0]) : __uint_as_float(rr[1]);
        TB[g] = IS[g + 1] + sel;
    }
    { const auto rr = __builtin_amdgcn_permlane32_swap(__float_as_uint(IS[0]), __float_as_uint(IS[0]), false, false);
      const float other = hi ? __uint_as_float(rr[0]) : __uint_as_float(rr[1]);
      Rm = IS[0] + other; }
#pragma unroll
    for (int g = 0; g < 8; ++g)
#pragma unroll
        for (int e = 0; e < 4; ++e) {
            const float z = (g < 4) ? p0[4 * g + e] : p1[4 * (g - 4) + e];
            const float a = fast_exp2(z - (TB[g] + I[g][e]));
            if (g < 4) p0[4 * g + e] = a; else p1[4 * (g - 4) + e] = a;
        }
#define PK4(P, BASE, OUT) do { unsigned a0 = cvt_pk_bf16(P[BASE + 0], P[BASE + 1]), a1 = cvt_pk_bf16(P[BASE + 2], P[BASE + 3]);   \
    unsigned b0 = cvt_pk_bf16(P[BASE + 4], P[BASE + 5]), b1 = cvt_pk_bf16(P[BASE + 6], P[BASE + 7]);                              \
    auto r0 = __builtin_amdgcn_permlane32_swap(a0, b0, false, false); auto r1 = __builtin_amdgcn_permlane32_swap(a1, b1, false, false); \
    u32x4 w = {r0[0], r1[0], r0[1], r1[1]}; OUT = __builtin_bit_cast(bf16x8, w); } while (0)
    PK4(p0, 0, pa0); PK4(p0, 8, pa1); PK4(p1, 0, pa2); PK4(p1, 8, pa3);
#undef PK4
}
constexpr int SHM_V = 16384, SHM_K = 16384;
__device__ __forceinline__ void attn_unit(const bf16* __restrict__ P, bf16* __restrict__ AO, int h, int qb, LAS unsigned char* lds, int tid, int wid, int lane) {
    const int r32 = lane & 31, hi = lane >> 5;
    LAS unsigned char* V_lds = lds; LAS unsigned char* K_lds = lds + 2 * SHM_V;
    const int t0 = qb * 256 + wid * 32;
    bf16x8 qr[8];
    { const bf16* Qw = P + (size_t)(t0 + r32) * DIN + OFF_Q + h * HD + hi * 8;
#pragma unroll
      for (int d0 = 0; d0 < 8; ++d0) qr[d0] = *(const bf16x8*)(Qw + d0 * 16); }
    const int sr = tid >> 4, sc = (tid & 15) * 8, vst0 = v_st(sr, sc), vst1 = v_st(32 + sr, sc);
    const int vb0 = (int)(unsigned)(uintptr_t)V_lds + v_rd_base(lane);
    const bf16* Kg = P + OFF_K + h * HD + sc; const bf16* Vg = P + OFF_V + h * HD + sc;
    bf16x8 vs0, vs1, ks0, ks1;
#define SLOAD(k0) do { vs0 = *(const bf16x8*)(Vg + (size_t)((k0) + sr) * DIN); vs1 = *(const bf16x8*)(Vg + (size_t)((k0) + 32 + sr) * DIN); \
    ks0 = *(const bf16x8*)(Kg + (size_t)((k0) + sr) * DIN); ks1 = *(const bf16x8*)(Kg + (size_t)((k0) + 32 + sr) * DIN); } while (0)
#define SWRITE(b) do { *(LAS bf16x8*)(V_lds + (b) * SHM_V + vst0) = vs0; *(LAS bf16x8*)(V_lds + (b) * SHM_V + vst1) = vs1; const int kc = sc * 2; \
    *(LAS bf16x8*)(K_lds + (b) * SHM_K + KSWZ(sr, kc)) = ks0; *(LAS bf16x8*)(K_lds + (b) * SHM_K + KSWZ(32 + sr, kc)) = ks1; } while (0)
    f32x16 o[4] = {};
    float Rm = 0.f;
    const int jtop = 4 * qb + 3, jw = 4 * qb + (wid >> 1);
    SLOAD(jtop * 64); VM_WAIT(); SWRITE(0); __syncthreads();
    for (int j = jtop; j >= 0; --j) {
        const int buf = (jtop - j) & 1;
        if (j > 0) SLOAD((j - 1) * 64);
        if (j <= jw) {
            f32x16 p0, p1;
            qkt(p0, p1, K_lds + buf * SHM_K, qr, r32, hi);
            if (j == jw) {
                const int t = t0 + r32, kb = j * 64;
#pragma unroll
                for (int r = 0; r < 16; ++r) { if (kb + crow(r, hi) >= t) p0[r] = -1e30f; if (kb + 32 + crow(r, hi) >= t) p1[r] = -1e30f; }
            }
            bf16x8 pa0, pa1, pa2, pa3;
            stick_tile(p0, p1, Rm, hi, pa0, pa1, pa2, pa3);
            const int vb = vb0 + buf * SHM_V;
            pv_one<0>(o[0], vb, pa0, pa1, pa2, pa3); pv_one<1>(o[1], vb, pa0, pa1, pa2, pa3); pv_one<2>(o[2], vb, pa0, pa1, pa2, pa3); pv_one<3>(o[3], vb, pa0, pa1, pa2, pa3);
        }
        if (j > 0) { VM_WAIT(); SWRITE(buf ^ 1); }
        __syncthreads();
    }
    bf16* Ow = AO + (size_t)t0 * SBW + h * HD;
#pragma unroll
    for (int r = 0; r < 16; ++r) { const int orow = crow(r, hi);
#pragma unroll
        for (int d0 = 0; d0 < 4; ++d0) Ow[(size_t)orow * SBW + d0 * 32 + r32] = f2bf(o[d0][r]); }
#undef SLOAD
#undef SWRITE
}
__device__ __forceinline__ void sgu_unit(const bf16* __restrict__ P, bf16* __restrict__ SO, const float* __restrict__ sgw, const float* __restrict__ sgb, const float* __restrict__ lng, const float* __restrict__ lnb,
                                         int c, int g, LAS unsigned char* lds, int tid, int wid, int lane) {
    const int r32 = lane & 31, hi = lane >> 5;
    {
        const int s = tid >> 2, qd = tid & 3;
        const bf16* src = P + (size_t)(c * 128 + s) * DIN + OFF_VG + g * 128 + qd * 32;
        float x[32];
#pragma unroll
        for (int i = 0; i < 4; ++i) { const u32x4 w = *(const u32x4*)(src + 8 * i);
#pragma unroll
            for (int j = 0; j < 4; ++j) { x[8 * i + 2 * j] = __builtin_bit_cast(float, w[j] << 16); x[8 * i + 2 * j + 1] = __builtin_bit_cast(float, w[j] & 0xffff0000u); } }
        float sm = 0.f;
#pragma unroll
        for (int i = 0; i < 32; ++i) sm += x[i];
        sm += __shfl_xor(sm, 1); sm += __shfl_xor(sm, 2);
        const float mu = sm * (1.f / 128.f);
        float q = 0.f;
#pragma unroll
        for (int i = 0; i < 32; ++i) { x[i] -= mu; q += x[i] * x[i]; }
        q += __shfl_xor(q, 1); q += __shfl_xor(q, 2);
        const float rstd = rsqrtf(q * (1.f / 128.f) + LN_EPS);
        const float* gg = lng + g * 128 + qd * 32; const float* bb = lnb + g * 128 + qd * 32;
#pragma unroll
        for (int i = 0; i < 4; ++i) { u32x4 w;
#pragma unroll
            for (int j = 0; j < 4; ++j) { const int ch = 8 * i + 2 * j; w[j] = cvt_pk_bf16(x[ch] * rstd * gg[ch] + bb[ch], x[ch + 1] * rstd * gg[ch + 1] + bb[ch + 1]); }
            *(LAS u32x4*)(lds + (s >> 6) * SHM_V + v_st(s & 63, qd * 32 + 8 * i)) = w; }
    }
    __syncthreads();
    const int tb = wid >> 1, dh = wid & 1;
    f32x16 o[2] = {};
    const int vb0 = (int)(unsigned)(uintptr_t)lds + v_rd_base(lane);
    const int t = 32 * tb + r32;
    const float* wrow = sgw + ((size_t)g * 128 + t) * 128;
#pragma unroll
    for (int kt = 0; kt < 2; ++kt) {
        if (64 * kt <= 32 * tb + 31) {
            bf16x8 pa[4];
#pragma unroll
            for (int ks = 0; ks < 4; ++ks) { const int s0 = 64 * kt + 16 * ks + 8 * hi;
                const f32x4 w0 = *(const f32x4*)(wrow + s0), w1 = *(const f32x4*)(wrow + s0 + 4);
                u32x4 w; w.x = cvt_pk_bf16(s0 + 0 <= t ? w0[0] : 0.f, s0 + 1 <= t ? w0[1] : 0.f); w.y = cvt_pk_bf16(s0 + 2 <= t ? w0[2] : 0.f, s0 + 3 <= t ? w0[3] : 0.f);
                w.z = cvt_pk_bf16(s0 + 4 <= t ? w1[0] : 0.f, s0 + 5 <= t ? w1[1] : 0.f); w.w = cvt_pk_bf16(s0 + 6 <= t ? w1[2] : 0.f, s0 + 7 <= t ? w1[3] : 0.f);
                pa[ks] = __builtin_bit_cast(bf16x8, w); }
            const int vb = vb0 + kt * SHM_V;
            if (dh == 0) { pv_one<0>(o[0], vb, pa[0], pa[1], pa[2], pa[3]); pv_one<1>(o[1], vb, pa[0], pa[1], pa[2], pa[3]); }
            else         { pv_one<2>(o[0], vb, pa[0], pa[1], pa[2], pa[3]); pv_one<3>(o[1], vb, pa[0], pa[1], pa[2], pa[3]); }
        }
    }
#pragma unroll
    for (int r = 0; r < 16; ++r) { const int tt = 32 * tb + crow(r, hi); const float bt = sgb[g * 128 + tt]; const size_t row = (size_t)(c * 128 + tt);
#pragma unroll
        for (int i = 0; i < 2; ++i) { const int d = 64 * dh + 32 * i + r32;
            const float u = bf2f(P[row * DIN + OFF_U + g * 128 + d]);
            SO[row * SBW + g * 128 + d] = f2bf(u * (o[i][r] + bt)); } }
    __syncthreads();
}
}

template <int MODE, bool ROUTE>
__device__ __forceinline__ void ln_phase(Frame& F, const float* __restrict__ Y, const float* __restrict__ X1, const float* __restrict__ YS, const int* __restrict__ tinfo, const float* __restrict__ tw,
                                         const float* __restrict__ g, const float* __restrict__ b, float* __restrict__ XF, bf16* __restrict__ XBo, const float* __restrict__ Wr, int* cnt, int* tinfo_o, float* tw_o) {
    const int gw = F.vcu * NWAVES + F.wave, NGW = F.G * NWAVES, lane = F.lane;
    for (int row = gw; row < S; row += NGW) {
        f32x4 v[8];
        if (MODE == 1) {
            const int e0 = tinfo[row * 4 + 0], p0 = tinfo[row * 4 + 1], e1 = tinfo[row * 4 + 2], p1 = tinfo[row * 4 + 3];
            const int r0 = 256 * (int)F.MISC[16 + e0] + p0, r1 = 256 * (int)F.MISC[16 + e1] + p1;
            const float w0 = tw[row * 2], w1 = tw[row * 2 + 1];
            const f32x4* x = (const f32x4*)(X1 + (size_t)row * D); const f32x4* y0 = (const f32x4*)(YS + (size_t)r0 * D); const f32x4* y1 = (const f32x4*)(YS + (size_t)r1 * D);
#pragma unroll
            for (int j = 0; j < 8; ++j) v[j] = x[lane + 64 * j] * ALPHA + (y0[lane + 64 * j] * w0 + y1[lane + 64 * j] * w1);
        } else {
            const f32x4* y = (const f32x4*)(Y + (size_t)row * D);
#pragma unroll
            for (int j = 0; j < 8; ++j) v[j] = y[lane + 64 * j];
        }
        float s = 0.f;
#pragma unroll
        for (int j = 0; j < 8; ++j) s += (v[j][0] + v[j][1]) + (v[j][2] + v[j][3]);
        const float mu = wave_sum(s) * (1.f / D);
        float q = 0.f;
#pragma unroll
        for (int j = 0; j < 8; ++j) { v[j] = v[j] - mu; q += (v[j][0] * v[j][0] + v[j][1] * v[j][1]) + (v[j][2] * v[j][2] + v[j][3] * v[j][3]); }
        const float rstd = rsqrtf(wave_sum(q) * (1.f / D) + LN_EPS);
#pragma unroll
        for (int j = 0; j < 8; ++j) { const f32x4 gg = ((const f32x4*)g)[lane + 64 * j], bb = ((const f32x4*)b)[lane + 64 * j];
            v[j] = v[j] * rstd * gg + bb;
            if (XF) ((f32x4*)(XF + (size_t)row * D))[lane + 64 * j] = v[j];
            if (XBo) { u32x2 w; w.x = cvt_pk_bf16(v[j][0], v[j][1]); w.y = cvt_pk_bf16(v[j][2], v[j][3]); ((u32x2*)(XBo + (size_t)row * D))[lane + 64 * j] = w; } }
        if (ROUTE) {
            float acc[NE];
#pragma unroll
            for (int e = 0; e < NE; ++e) acc[e] = 0.f;
#pragma unroll
            for (int j = 0; j < 8; ++j)
#pragma unroll
                for (int i = 0; i < 4; ++i) { const int d = 4 * (lane + 64 * j) + i; const float xv = v[j][i];
                    const f32x4 w0 = *(const f32x4*)(Wr + (size_t)d * NE), w1 = *(const f32x4*)(Wr + (size_t)d * NE + 4);
                    acc[0] = fmaf(xv, w0[0], acc[0]); acc[1] = fmaf(xv, w0[1], acc[1]); acc[2] = fmaf(xv, w0[2], acc[2]); acc[3] = fmaf(xv, w0[3], acc[3]);
                    acc[4] = fmaf(xv, w1[0], acc[4]); acc[5] = fmaf(xv, w1[1], acc[5]); acc[6] = fmaf(xv, w1[2], acc[6]); acc[7] = fmaf(xv, w1[3], acc[7]); }
#pragma unroll
            for (int e = 0; e < NE; ++e) acc[e] = wave_sum(acc[e]);
            if (lane == 0) {
                int i0 = 0; float l0 = acc[0];
#pragma unroll
                for (int e = 1; e < NE; ++e) if (acc[e] > l0) { l0 = acc[e]; i0 = e; }
                int i1 = -1; float l1 = -3.4e38f;
#pragma unroll
                for (int e = 0; e < NE; ++e) if (e != i0 && acc[e] > l1) { l1 = acc[e]; i1 = e; }
                const float e1 = expf(l1 - l0), w0 = 1.f / (1.f + e1), w1 = e1 / (1.f + e1);
                const int p0 = atomicAdd(&cnt[i0], 1), p1 = atomicAdd(&cnt[i1], 1);
                tinfo_o[row * 4 + 0] = i0; tinfo_o[row * 4 + 1] = p0; tinfo_o[row * 4 + 2] = i1; tinfo_o[row * 4 + 3] = p1;
                tw_o[row * 2] = w0; tw_o[row * 2 + 1] = w1;
            }
        }
    }
}
__device__ __forceinline__ void moe_table(Frame& F, const int* cnt) {
    if (F.tid == 0) { int acc = 0;
        for (int e = 0; e < NE; ++e) { F.MISC[16 + e] = (unsigned)acc; acc += (__hip_atomic_load(cnt + e, RLX_AGENT) + 255) / 256; }
        F.MISC[16 + NE] = (unsigned)acc; }
    __syncthreads();
}
__device__ __forceinline__ void gather_phase(Frame& F, const bf16* __restrict__ X1B, const int* __restrict__ tinfo, bf16* __restrict__ XG) {
    const int gw = F.vcu * NWAVES + F.wave, NGW = F.G * NWAVES, lane = F.lane;
    for (int it = gw; it < 2 * S; it += NGW) {
        const int t = it >> 1, k = it & 1;
        const int e = tinfo[t * 4 + 2 * k], pos = tinfo[t * 4 + 2 * k + 1];
        const int row = 256 * (int)F.MISC[16 + e] + pos;
        const u32x4* src = (const u32x4*)(X1B + (size_t)t * D); u32x4* dst = (u32x4*)(XG + (size_t)row * D);
#pragma unroll
        for (int j = 0; j < 4; ++j) dst[lane + 64 * j] = src[lane + 64 * j];
    }
}

constexpr int N_PHASES = 18;
__global__ void __launch_bounds__(NTHREADS, 2) mega(Params p) {
    extern __shared__ __attribute__((aligned(16))) unsigned char lds_raw[];
    Frame F;
    F.lds = (LAS unsigned char*)lds_raw;
    F.MISC = (volatile LAS unsigned*)(F.lds + MISC_OFF);
    F.tid = threadIdx.x; F.lane = F.tid & 63; F.wave = __builtin_amdgcn_readfirstlane(F.tid >> 6);
    F.G = gridDim.x; { const int bx = blockIdx.x; F.vcu = (F.G % 8 == 0) ? (bx % 8) * (F.G / 8) + bx / 8 : bx; }
    unsigned char* ws = p.ws;
    F.ctl = (gu32*)(ws + WS_CTL);
    for (int u = F.tid; u < (LDS_BYTES - LDSCTL_OFF) / 4; u += NTHREADS) ((LAS unsigned*)(F.lds + LDSCTL_OFF))[u] = 0u;
    __syncthreads();
    const int lo = p.ph_lo, hi = p.ph_hi;
    XcdBarrier bar; bar.bar = (unsigned*)(ws + WS_CTL) + CW_BAR + p.li * XCD_BAR_WORDS; bar.x = 0; bar.st = nullptr;
    if (hi - lo > 1) bar = xcd_barrier_post((unsigned*)(ws + WS_CTL) + CW_BAR + p.li * XCD_BAR_WORDS, F.MISC + 8);
#ifndef PH_ENABLE
#define PH_ENABLE 0x3FFFFu
#endif
#define IN(k) ((((unsigned)PH_ENABLE >> ((k) % 32)) & 1u) && lo <= (k) && (k) < hi)
#define SEAM(k) do { if (IN(k) && IN((k) + 1)) xcd_barrier(bar); } while (0)

    int* cnt = (int*)(ws + WS_CTL) + CW_CNT; int* tinfo = (int*)(ws + WS_TINFO); float* tw = (float*)(ws + WS_TW);
    bf16* XB = (bf16*)(ws + WS_XB); float* XC = (float*)(ws + WS_XC); float* X1 = (float*)(ws + WS_X1); bf16* X1B = (bf16*)(ws + WS_X1B);
    float* Y = (float*)(ws + WS_Y); bf16* XG = (bf16*)(ws + WS_XG); float* YS = (float*)(ws + WS_YS);
    bf16* P = (bf16*)(ws + WS_P); bf16* AO = (bf16*)(ws + WS_AO); bf16* SO = (bf16*)(ws + WS_SO); float* T = (float*)(ws + WS_T); bf16* MG = (bf16*)(ws + WS_MG);
    bf16* H = (bf16*)(ws + WS_H);
    const int bx = (int)blockIdx.x;

    if (IN(0)) { p0_convert(F, p); } SEAM(0);

#define COMMON_PHASES(layer) do { \
        const int pb = 1 + 8 * layer; \
        const float* xres = layer == 0 ? p.in[0] : XC; \
        if (IN(pb + 0)) { \
            pg8::SchedPlain Sc; Sc.init(XB, D, (const bf16*)(ws + WS_WIN) + (size_t)layer * DIN * D, D, S, DIN, F.G, bx); \
            pg8::EpiProj E{P, p.in[2] + layer * 2 * D}; \
            pg8::gemm_phase<pg8::EpiProj, pg8::SchedPlain>(F.lds, D, D, D, Sc, E); \
        } SEAM(pb + 0); \
        if (IN(pb + 1)) { \
            if (p.sub & 1) for (int u = F.vcu; u < NH * (S / 256); u += F.G) att::attn_unit(P, AO, u / (S / 256), u % (S / 256), F.lds, F.tid, F.wave, F.lane); \
            if (p.sub & 2) for (int u = F.vcu; u < (S / 128) * NG; u += F.G) \
                att::sgu_unit(P, SO, p.in[3] + (size_t)layer * NG * 128 * 128, p.in[4] + layer * NG * 128, p.in[5] + layer * SBW, p.in[6] + layer * SBW, u >> 3, u & 7, F.lds, F.tid, F.wave, F.lane); \
        } SEAM(pb + 1); \
        if (IN(pb + 2)) { \
            pg8::SchedTwoSeg Sc; Sc.init(AO, SO, SBW, (const bf16*)(ws + WS_WA) + (size_t)layer * D * SBW, (const bf16*)(ws + WS_WB) + (size_t)layer * D * SBW, SBW, S, D, F.G, bx); \
            pg8::EpiBranch E{T, MG, P}; \
            pg8::gemm_phase<pg8::EpiBranch, pg8::SchedTwoSeg>(F.lds, SBW, SBW, SBW, Sc, E); \
        } SEAM(pb + 2); \
        if (IN(pb + 3)) { \
            pg8::SchedPlain Sc; Sc.init(MG, D, (const bf16*)(ws + WS_WOUT) + (size_t)layer * D * D, D, S, D, F.G, bx); \
            pg8::EpiResid E{Y, xres}; \
            pg8::gemm_phase<pg8::EpiResid, pg8::SchedPlain>(F.lds, D, D, D, Sc, E); \
        } SEAM(pb + 3); \
    } while (0)
    COMMON_PHASES(0);

            if (IN(5)) { ln_phase<0, false>(F, Y, nullptr, nullptr, nullptr, nullptr, p.in[10], p.in[11], X1, X1B, nullptr, nullptr, nullptr, nullptr); } SEAM(5);
            if (IN(6)) {
                pg8::SchedPlain Sc; Sc.init(X1B, D, (const bf16*)(ws + WS_W13D), D, S, 2 * FF_D, F.G, bx);
                pg8::EpiSwiGlu E{H, FF_D};
                pg8::gemm_phase<pg8::EpiSwiGlu, pg8::SchedPlain>(F.lds, D, D, D, Sc, E);
            } SEAM(6);
            if (IN(7)) {
                pg8::SchedPlain Sc; Sc.init(H, FF_D, (const bf16*)(ws + WS_W2D), FF_D, S, D, F.G, bx);
                pg8::EpiResid E{Y, X1};
                pg8::gemm_phase<pg8::EpiResid, pg8::SchedPlain>(F.lds, FF_D, FF_D, FF_D, Sc, E);
            } SEAM(7);
            if (IN(8)) { ln_phase<0, false>(F, Y, nullptr, nullptr, nullptr, nullptr, p.in[19], p.in[20], XC, XB, nullptr, nullptr, nullptr, nullptr); } SEAM(8);
    COMMON_PHASES(1);

            if (IN(13)) { ln_phase<0, true>(F, Y, nullptr, nullptr, nullptr, nullptr, p.in[10] + D, p.in[11] + D, X1, X1B, p.in[15], cnt, tinfo, tw); } SEAM(13);
            if (IN(14)) { moe_table(F, cnt); gather_phase(F, X1B, tinfo, XG); } SEAM(14);
            if (IN(15)) {
                moe_table(F, cnt);
                pg8::SchedMoe Sc; Sc.init(XG, D, (const bf16*)(ws + WS_W13E), D, 2 * FF_E, (const volatile LAS int*)(F.MISC + 16), F.G, bx);
                pg8::EpiSwiGlu E{H, FF_E};
                pg8::gemm_phase<pg8::EpiSwiGlu, pg8::SchedMoe>(F.lds, D, D, D, Sc, E);
            } SEAM(15);
            if (IN(16)) {
                moe_table(F, cnt);
                pg8::SchedMoe Sc; Sc.init(H, FF_E, (const bf16*)(ws + WS_W2E), FF_E, D, (const volatile LAS int*)(F.MISC + 16), F.G, bx);
                pg8::EpiResid E{YS, nullptr};
                pg8::gemm_phase<pg8::EpiResid, pg8::SchedMoe>(F.lds, FF_E, FF_E, FF_E, Sc, E);
            } SEAM(16);
            if (IN(17)) { moe_table(F, cnt); ln_phase<1, false>(F, nullptr, X1, YS, tinfo, tw, p.in[19] + D, p.in[20] + D, p.out, nullptr, nullptr, nullptr, nullptr, nullptr); }
#undef COMMON_PHASES
#undef IN
#undef SEAM
}
}

#ifndef NEW_MASK
#define NEW_MASK 0x3FFFFu
#endif
#ifndef NEW_ATT
#define NEW_ATT 1
#endif
#ifndef NEW_SGU
#define NEW_SGU 1
#endif
#ifndef FUSE
#define FUSE 1
#endif
extern "C" void kernel_launch(void* const* d_in, const int* in_sizes, int n_in, void* d_out, int out_size, void* d_ws, size_t ws_size, hipStream_t stream) {
    static int grid = 0;
    if (grid == 0) {
        if (n_in != 21 || ws_size < WS_END) { fprintf(stderr, "kernel_launch: unexpected n_in %d / ws %zu (need %zu)\n", n_in, ws_size, (size_t)WS_END); grid = -1; return; }
        int dev = 0, cus = 0, per_cu = 0;
        if (hipGetDevice(&dev) != hipSuccess || hipDeviceGetAttribute(&cus, hipDeviceAttributeMultiprocessorCount, dev) != hipSuccess) { grid = -1; return; }
        if (hipFuncSetAttribute((const void*)mk::mega, hipFuncAttributeMaxDynamicSharedMemorySize, mk::LDS_BYTES) != hipSuccess) { fprintf(stderr, "kernel_launch: hipFuncSetAttribute failed\n"); grid = -1; return; }
        if (hipOccupancyMaxActiveBlocksPerMultiprocessor(&per_cu, (const void*)mk::mega, mk::NTHREADS, mk::LDS_BYTES) != hipSuccess || per_cu < 1) { fprintf(stderr, "kernel_launch: occupancy query says %d\n", per_cu); }
        (void)hipGetLastError();
        grid = cus;
    }
    if (grid < 0) return;
    char* ws = (char*)d_ws;
    (void)hipMemsetAsync(ws + WS_CTL, 0, CTL_ZERO_BYTES, stream);
    mk::Params prm{};
    for (int i = 0; i < 21; ++i) prm.in[i] = (const float*)d_in[i];
    prm.out = (float*)d_out; prm.ws = (unsigned char*)d_ws; prm.sub = (NEW_ATT ? 1 : 0) | (NEW_SGU ? 2 : 0);
    const unsigned mask = NEW_MASK;
#if NEW_MASK != 0x3FFFFu || !NEW_ATT || !NEW_SGU
    const float* x_in = (const float*)d_in[0];
    const float* w_in = (const float*)d_in[1];   const float* b_gate = (const float*)d_in[2];
    const float* sg_w = (const float*)d_in[3];   const float* sg_b = (const float*)d_in[4];
    const float* sg_ln_g = (const float*)d_in[5]; const float* sg_ln_b = (const float*)d_in[6];
    const float* w_a = (const float*)d_in[7];    const float* w_b = (const float*)d_in[8];   const float* w_out = (const float*)d_in[9];
    const float* ln1_g = (const float*)d_in[10]; const float* ln1_b = (const float*)d_in[11];
    const float* ffn_w1 = (const float*)d_in[12]; const float* ffn_w3 = (const float*)d_in[13]; const float* ffn_w2 = (const float*)d_in[14];
    const float* moe_router = (const float*)d_in[15];
    const float* moe_w1 = (const float*)d_in[16]; const float* moe_w3 = (const float*)d_in[17]; const float* moe_w2 = (const float*)d_in[18];
    const float* ln2_g = (const float*)d_in[19]; const float* ln2_b = (const float*)d_in[20];
    float* out = (float*)d_out;
    int* cnt = (int*)(ws + WS_CTL) + CW_CNT; int* tinfo = (int*)(ws + WS_TINFO); float* tw = (float*)(ws + WS_TW);
    bf16* XB = (bf16*)(ws + WS_XB); float* XC = (float*)(ws + WS_XC); float* X1 = (float*)(ws + WS_X1); bf16* X1B = (bf16*)(ws + WS_X1B);
    float* Y = (float*)(ws + WS_Y); bf16* XG = (bf16*)(ws + WS_XG); float* YS = (float*)(ws + WS_YS);
    bf16* P = (bf16*)(ws + WS_P); bf16* AO = (bf16*)(ws + WS_AO); bf16* SO = (bf16*)(ws + WS_SO); float* T = (float*)(ws + WS_T); bf16* MG = (bf16*)(ws + WS_MG);
    bf16* H = (bf16*)(ws + WS_H); float* LNV = T;
    const dim3 blk(256);
#endif
    int li = 0;
    for (int ph = 0; ph < mk::N_PHASES;) {
        if (mask & (1u << ph)) {
            int hi = ph + 1;
            if (FUSE) while (hi < mk::N_PHASES && (mask & (1u << hi)) && !(((hi - 1) == 2 || (hi - 1) == 10) && !(NEW_ATT && NEW_SGU))) ++hi;
            prm.ph_lo = ph; prm.ph_hi = hi; prm.li = li++;
            hipLaunchKernelGGL(mk::mega, dim3(grid), dim3(mk::NTHREADS), mk::LDS_BYTES, stream, prm);
#if NEW_MASK != 0x3FFFFu || !NEW_ATT || !NEW_SGU
            if (ph <= 2 && 2 < hi) { if (!NEW_ATT) hipLaunchKernelGGL(nv::attn, dim3(S * NH / 4), blk, 0, stream, P, AO);
                if (!NEW_SGU) { hipLaunchKernelGGL(nv::sgu_ln, dim3(S * NG / 4), blk, 0, stream, P, sg_ln_g, sg_ln_b, LNV); hipLaunchKernelGGL(nv::sgu_mix, dim3(64 * NG), blk, 0, stream, P, LNV, sg_w, sg_b, SO); } }
            if (ph <= 10 && 10 < hi) { if (!NEW_ATT) hipLaunchKernelGGL(nv::attn, dim3(S * NH / 4), blk, 0, stream, P, AO);
                if (!NEW_SGU) { hipLaunchKernelGGL(nv::sgu_ln, dim3(S * NG / 4), blk, 0, stream, P, sg_ln_g + SBW, sg_ln_b + SBW, LNV); hipLaunchKernelGGL(nv::sgu_mix, dim3(64 * NG), blk, 0, stream, P, LNV, sg_w + (size_t)NG * 128 * 128, sg_b + NG * 128, SO); } }
#endif
            ph = hi; continue;
        }
#if NEW_MASK != 0x3FFFFu || !NEW_ATT || !NEW_SGU
        const int layer = ph >= 9 ? 1 : 0; const int k = ph == 0 ? -1 : (ph - 1) % 8 + (ph >= 14 ? 8 : 0);
        const float* xres = layer == 0 ? x_in : XC;
        if (ph == 0) hipLaunchKernelGGL(nv::cvt_bf16, dim3(2048), blk, 0, stream, x_in, XB, (size_t)S * D / 4);
        else if (ph == 1 || ph == 9) hipLaunchKernelGGL((nv::gemm<bf16, nv::EpiProj, false>), dim3(DIN / 64, S / 64), blk, 0, stream, XB, nullptr, w_in + (size_t)layer * D * DIN, nullptr, D, 0, DIN, S, DIN, D, nv::EpiProj{P, b_gate + layer * 2 * D});
        else if (ph == 2 || ph == 10) { hipLaunchKernelGGL(nv::attn, dim3(S * NH / 4), blk, 0, stream, P, AO);
            hipLaunchKernelGGL(nv::sgu_ln, dim3(S * NG / 4), blk, 0, stream, P, sg_ln_g + layer * SBW, sg_ln_b + layer * SBW, LNV);
            hipLaunchKernelGGL(nv::sgu_mix, dim3(64 * NG), blk, 0, stream, P, LNV, sg_w + (size_t)layer * NG * 128 * 128, sg_b + layer * NG * 128, SO); }
        else if (ph == 3 || ph == 11) { hipLaunchKernelGGL((nv::gemm<bf16, nv::EpiGateA, false>), dim3(D / 64, S / 64), blk, 0, stream, AO, nullptr, w_a + (size_t)layer * SBW * D, nullptr, SBW, 0, D, S, D, SBW, nv::EpiGateA{T, P});
            hipLaunchKernelGGL((nv::gemm<bf16, nv::EpiGateB, false>), dim3(D / 64, S / 64), blk, 0, stream, SO, nullptr, w_b + (size_t)layer * SBW * D, nullptr, SBW, 0, D, S, D, SBW, nv::EpiGateB{T, P, MG}); }
        else if (ph == 4 || ph == 12) hipLaunchKernelGGL((nv::gemm<bf16, nv::EpiResid, false>), dim3(D / 64, S / 64), blk, 0, stream, MG, nullptr, w_out + (size_t)layer * D * D, nullptr, D, 0, D, S, D, D, nv::EpiResid{Y, xres});
        else if (ph == 5) hipLaunchKernelGGL(nv::ln_rows, dim3(S / 4), blk, 0, stream, Y, nullptr, nullptr, nullptr, nullptr, nullptr, ln1_g, ln1_b, X1, X1B);
        else if (ph == 6) hipLaunchKernelGGL((nv::gemm<bf16, nv::EpiSwiGlu, true>), dim3(FF_D / 64, S / 64), blk, 0, stream, X1B, nullptr, ffn_w1, ffn_w3, D, 0, FF_D, S, FF_D, D, nv::EpiSwiGlu{H, FF_D});
        else if (ph == 7) hipLaunchKernelGGL((nv::gemm<bf16, nv::EpiResid, false>), dim3(D / 64, S / 64), blk, 0, stream, H, nullptr, ffn_w2, nullptr, FF_D, 0, D, S, D, FF_D, nv::EpiResid{Y, X1});
        else if (ph == 8) hipLaunchKernelGGL(nv::ln_rows, dim3(S / 4), blk, 0, stream, Y, nullptr, nullptr, nullptr, nullptr, nullptr, ln2_g, ln2_b, XC, XB);
        else if (ph == 13) { hipLaunchKernelGGL(nv::ln_rows, dim3(S / 4), blk, 0, stream, Y, nullptr, nullptr, nullptr, nullptr, nullptr, ln1_g + D, ln1_b + D, X1, X1B);
            hipLaunchKernelGGL(nv::moe_route, dim3(S / 4), blk, 0, stream, X1, moe_router, cnt, tinfo, tw); }
        else if (ph == 14) hipLaunchKernelGGL(nv::moe_gather, dim3(S * 2 / 4), blk, 0, stream, X1B, tinfo, cnt, XG);
        else if (ph == 15) { for (int e = 0; e < NE; ++e) hipLaunchKernelGGL((nv::gemm<bf16, nv::EpiSwiGlu, true>), dim3(FF_E / 64, S / 64), blk, 0, stream, XG, cnt, moe_w1 + (size_t)e * D * FF_E, moe_w3 + (size_t)e * D * FF_E, D, e, FF_E, S, FF_E, D, nv::EpiSwiGlu{H, FF_E}); }
        else if (ph == 16) { for (int e = 0; e < NE; ++e) hipLaunchKernelGGL((nv::gemm<bf16, nv::EpiStoreF, false>), dim3(D / 64, S / 64), blk, 0, stream, H, cnt, moe_w2 + (size_t)e * FF_E * D, nullptr, FF_E, e, D, S, D, FF_E, nv::EpiStoreF{YS, D}); }
        else if (ph == 17) hipLaunchKernelGGL(nv::ln_rows, dim3(S / 4), blk, 0, stream, nullptr, X1, YS, tinfo, tw, cnt, ln2_g + D, ln2_b + D, out, nullptr);
        (void)k;
#endif
        ++ph;
    }
}
```

```cpp
#define NEW_MASK 0x3FFFF
#include <hip/hip_runtime.h>
#include <cstdio>
#include <cstdint>

typedef unsigned short bf16;
constexpr int S = 8192, D = 2048, DIN = 9216, SBW = 1024, NH = 8, HD = 128, NG = 8;
constexpr int OFF_Q = 0, OFF_K = 1024, OFF_V = 2048, OFF_U = 3072, OFF_VG = 4096, OFF_GATE = 5120;
constexpr int FF_D = 5504, FF_E = 7168, NE = 8;
constexpr int MAXSLOT = 2 * S + NE * 256;
constexpr float ALPHA = 1.4142135623730951f;
constexpr float LN_EPS = 1e-5f;
constexpr float QSCALE = 0.08838834764831845f * 1.4426950408889634f;

__host__ __device__ __forceinline__ unsigned f2bf_u(float f) { unsigned u = __builtin_bit_cast(unsigned, f); return (u + 0x7fffu + ((u >> 16) & 1u)) >> 16; }
__host__ __device__ __forceinline__ bf16 f2bf(float f) { return (bf16)f2bf_u(f); }
__host__ __device__ __forceinline__ float bf2f(bf16 b) { return __builtin_bit_cast(float, ((unsigned)b) << 16); }
__host__ __device__ __forceinline__ unsigned pk2(float lo, float hi) { return f2bf_u(lo) | (f2bf_u(hi) << 16); }

constexpr size_t MiB = 1u << 20;
constexpr size_t WS_CTL = 0, CTL_ZERO_BYTES = 1 * MiB;
constexpr size_t WS_TINFO = 1 * MiB;
constexpr size_t WS_TW = WS_TINFO + (size_t)S * 16;
constexpr size_t WS_WIN = 2 * MiB;
constexpr size_t WS_WA = WS_WIN + 72 * MiB;
constexpr size_t WS_WB = WS_WA + 8 * MiB;
constexpr size_t WS_WOUT = WS_WB + 8 * MiB;
constexpr size_t WS_W13D = WS_WOUT + 16 * MiB;
constexpr size_t WS_W2D = WS_W13D + 43 * MiB;
constexpr size_t WS_W13E = WS_W2D + 22 * MiB;
constexpr size_t WS_W2E = WS_W13E + 448 * MiB;
constexpr size_t WS_XB = WS_W2E + 224 * MiB;
constexpr size_t WS_XC = WS_XB + 32 * MiB;
constexpr size_t WS_X1 = WS_XC + 64 * MiB;
constexpr size_t WS_X1B = WS_X1 + 64 * MiB;
constexpr size_t WS_Y = WS_X1B + 32 * MiB;
constexpr size_t WS_XG = WS_Y;
constexpr size_t WS_YS = WS_Y + 72 * MiB;
constexpr size_t WS_A = WS_YS + 144 * MiB;
constexpr size_t WS_P = WS_A;
constexpr size_t WS_AO = WS_P + 144 * MiB;
constexpr size_t WS_SO = WS_AO + 16 * MiB;
constexpr size_t WS_T = WS_SO + 16 * MiB;
constexpr size_t WS_MG = WS_T + 64 * MiB;
constexpr size_t WS_H = WS_A;
constexpr size_t WS_END = WS_A + 272 * MiB;
static_assert(WS_MG + 32 * MiB == WS_END && WS_END <= 1792 * MiB, "d_ws map");
constexpr int CW_TMO = 0, CW_CODE = 1;
constexpr int CW_CNT = 64;
constexpr int CW_BAR = 4096;
namespace mk {
#define LAS __attribute__((address_space(3)))
#define GAS __attribute__((address_space(1)))
typedef short bf16x8 __attribute__((ext_vector_type(8)));
typedef short s16x4 __attribute__((ext_vector_type(4)));
typedef float f32x2 __attribute__((ext_vector_type(2)));
typedef float f32x4 __attribute__((ext_vector_type(4)));
typedef float f32x16 __attribute__((ext_vector_type(16)));
typedef unsigned u32x2 __attribute__((ext_vector_type(2)));
typedef unsigned u32x4 __attribute__((ext_vector_type(4)));
typedef GAS unsigned gu32;

constexpr int NWAVES = 8, NTHREADS = 512;
struct Params { const float* in[21]; float* out; unsigned char* ws; int ph_lo, ph_hi, li, sub; };
static_assert(sizeof(Params) == 21 * 8 + 8 + 8 + 16, "Params has no holes");
constexpr int RING_BYTES = 131072;
constexpr int LDSCTL_OFF = RING_BYTES, MISC_OFF = LDSCTL_OFF + 320;
constexpr int LDS_BYTES = 147456;
#define RLX_AGENT __ATOMIC_RELAXED, __HIP_MEMORY_SCOPE_AGENT
#define LDS_WAIT() asm volatile("s_waitcnt lgkmcnt(0)" ::: "memory")
#define VM_WAIT() asm volatile("s_waitcnt vmcnt(0)" ::: "memory")
#define SBAR() __builtin_amdgcn_sched_barrier(0)

__device__ __forceinline__ unsigned cvt_pk_bf16(float lo, float hi) { unsigned r; asm volatile("v_cvt_pk_bf16_f32 %0, %1, %2" : "=v"(r) : "v"(lo), "v"(hi)); return r; }
__device__ __forceinline__ float fast_exp2(float x) { return __builtin_amdgcn_exp2f(x); }
__device__ __forceinline__ float fast_log2(float x) { return __builtin_amdgcn_logf(x); }
__device__ __forceinline__ float fast_rcp(float x) { return __builtin_amdgcn_rcpf(x); }
__device__ __forceinline__ float sigmoid_f(float x) { return fast_rcp(1.f + fast_exp2(-1.4426950408889634f * x)); }
__device__ __forceinline__ float gelu_tanh_f(float x) { const float y2 = 2.f * 0.7978845608028654f * 1.4426950408889634f * (x + 0.044715f * x * x * x); return x * fast_rcp(1.f + fast_exp2(-y2)); }

#define XB_TMO      128
#define XB_XCNT(j)  (256  + 64 * (j))
#define XB_XSUB(j)  (1280 + 64 * (j))
#define XB_XGEN(j)  (2304 + 64 * (j))
#define XB_TOP      3328
#define XB_TOPGEN   3392
#define XCD_BAR_WORDS 3456
#define XB_SPIN_CAP (1u << 22)
__device__ __forceinline__ unsigned xb_ld(unsigned* p)              { return __hip_atomic_load(p, __ATOMIC_RELAXED, __HIP_MEMORY_SCOPE_AGENT); }
__device__ __forceinline__ unsigned xb_add(unsigned* p, unsigned v) { return __hip_atomic_fetch_add(p, v, __ATOMIC_RELAXED, __HIP_MEMORY_SCOPE_AGENT); }
__device__ __forceinline__ unsigned xb_xcc_id() { return (unsigned)__builtin_amdgcn_s_getreg((3 << 11) | 20) & 0xFu; }
#define XB_SPIN(cond, bar) do { unsigned _sp = 0; while (cond) { __builtin_amdgcn_s_sleep(1); \
    if ((++_sp & 255u) == 0u) { if (xb_ld(&(bar)[XB_TMO])) break; if (_sp > XB_SPIN_CAP) { atomicAdd(&(bar)[XB_TMO], 1u); break; } } } } while (0)
struct XcdBarrier { unsigned* bar; unsigned x; volatile LAS unsigned* st; };
__device__ __forceinline__ XcdBarrier xcd_barrier_post(unsigned* bar, volatile LAS unsigned* st) {
    XcdBarrier b; b.bar = bar; b.x = xb_xcc_id(); b.st = st;
    if (threadIdx.x == 0) (void)xb_add(&bar[XB_XCNT(b.x)], 1u);
    return b;
}
__device__ __forceinline__ void xcd_barrier_complete(unsigned* bar, unsigned x, unsigned& nloc, unsigned& nx) {
    const unsigned G = gridDim.x * gridDim.y * gridDim.z;
    unsigned sum, cnt, mine, sp = 0u;
    for (;;) {
        sum = 0u; cnt = 0u; mine = 0u;
#pragma unroll
        for (unsigned j = 0; j < 16; ++j) { const unsigned c = xb_ld(&bar[XB_XCNT(j)]); sum += c; cnt += (c > 0u) ? 1u : 0u; mine = (j == x) ? c : mine; }
        if (sum == G) break;
        __builtin_amdgcn_s_sleep(1);
        if ((++sp & 255u) == 0u) { if (xb_ld(&bar[XB_TMO])) break; if (sp > XB_SPIN_CAP) { atomicAdd(&bar[XB_TMO], 1u); break; } }
    }
    nloc = mine > 0u ? mine : 1u; nx = cnt > 0u ? cnt : 1u;
}
__device__ __forceinline__ void xcd_barrier(const XcdBarrier& b) {
    asm volatile("s_waitcnt vmcnt(0)" ::: "memory");
    __syncthreads();
    if (threadIdx.x == 0) {
        unsigned* bar = b.bar;
        __builtin_amdgcn_s_waitcnt(0);
        unsigned nloc = b.st[0], nx = b.st[1];
        if (nloc == 0u) { xcd_barrier_complete(bar, b.x, nloc, nx); b.st[0] = nloc; b.st[1] = nx; }
        const unsigned old = xb_add(&bar[XB_XSUB(b.x)], 1u);
        const unsigned gen = old / nloc;
        if (old + 1u == (gen + 1u) * nloc) {
            __builtin_amdgcn_fence(__ATOMIC_RELEASE, "agent");
            asm volatile("s_waitcnt vmcnt(0)" ::: "memory");
            const unsigned og = xb_add(&bar[XB_TOP], 1u);
            const unsigned tg = og / nx;
            if (og + 1u == (tg + 1u) * nx) xb_add(&bar[XB_TOPGEN], 1u);
            else XB_SPIN(xb_ld(&bar[XB_TOPGEN]) == tg, bar);
            __builtin_amdgcn_fence(__ATOMIC_ACQUIRE, "agent");
            xb_add(&bar[XB_XGEN(b.x)], 1u);
            asm volatile("s_waitcnt vmcnt(0)" ::: "memory");
        } else {
            XB_SPIN(xb_ld(&bar[XB_XGEN(b.x)]) == gen, bar);
            __builtin_amdgcn_fence(__ATOMIC_ACQUIRE, "agent");
            asm volatile("s_waitcnt vmcnt(0)" ::: "memory");
        }
    }
    __syncthreads();
}

namespace pg8 {
constexpr int BM = 256, BK = 64, HALF = 128, HTB = HALF * BK * 2, STAGE_BYTES = 8 * HTB, NXCD = 8, WGM = 8;
__host__ __device__ __forceinline__ int lds_byte(int r, int c) { const int st = (r >> 4) * 2 + (c >> 5), rr = r & 15, cc = c & 31, ob = rr * 64 + cc * 2; return st * 1024 + (ob ^ (((ob >> 9) & 1) << 5)); }
__host__ __device__ __forceinline__ void stage_rc(int b, int& R, int& C) { const int st = b / 1024, sb = b % 1024, swz = sb ^ (((sb >> 9) & 1) << 5); R = (st >> 1) * 16 + swz / 64; C = (st & 1) * 32 + (swz % 64) / 2; }
__host__ __device__ __forceinline__ int perm32(int rho) { const int n = rho >> 4, i = rho & 15; return 8 * (i >> 2) + 4 * n + (i & 3); }

struct Unit { int pm, pn, kind, aux; const char* a; const char* b0; const char* b1; };
struct TileOrder {
    int nM, nN, nwg, G, c;
    __device__ __forceinline__ void init(int nM_, int nN_, int G_, int c_) { nM = nM_; nN = nN_; nwg = nM * nN; G = G_; c = c_; }
    __device__ __forceinline__ bool map(int i, int& pm, int& pn) const {
        const long L = (long)i * G + c; if (L >= nwg) return false;
        int wgid = (int)L; { const int q = nwg / NXCD, r = nwg % NXCD, xcd = wgid % NXCD, off = wgid / NXCD; wgid = (xcd < r ? xcd * (q + 1) : r * (q + 1) + (xcd - r) * q) + off; }
        const int nig = WGM * nN, gid = wgid / nig, fm = gid * WGM, gsz = (nM - fm) < WGM ? (nM - fm) : WGM;
        pm = fm + ((wgid % nig) % gsz); pn = (wgid % nig) / gsz; return true;
    }
};

template <class Epi, class Sched>
__device__ __forceinline__ void gemm_phase(LAS unsigned char* lds, const int lda, const int ldb, const int K, const Sched& S, const Epi& E) {
    const int tid = threadIdx.x, wid = __builtin_amdgcn_readfirstlane(tid >> 6), lane = tid & 63, wr = wid >> 2, wc = wid & 3, fr = lane & 15, fq = lane >> 4;
    const int nt = K / BK;
    unsigned voffA[2], voffB[2];
#pragma unroll
    for (int i = 0; i < 2; ++i) { int R, C; stage_rc(tid * 16 + i * 8192, R, C); const int Rb = Epi::PERM ? ((R & ~31) + perm32(R & 31)) : R;
        voffA[i] = (unsigned)(R * lda + C) * 2u; voffB[i] = (unsigned)(Rb * ldb + C) * 2u; }
    const size_t kstep = (size_t)(BK * 2);
    const size_t hstepA = (size_t)HALF * lda * 2;
    const unsigned ldsw = (unsigned)wid * 1024u;
    const int aoff = lds_byte(wr * 64 + fr, fq * 8), boff = lds_byte(wc * 32 + fr, fq * 8);
#define PG8_SA(b, h) (((b) * 2 + (h)) * HTB)
#define PG8_SB(b, h) ((4 + (b) * 2 + (h)) * HTB)
#define PG8_STAGE(bufoff, gbase, voff) do { _Pragma("unroll") for (int _i = 0; _i < 2; ++_i) \
        __builtin_amdgcn_global_load_lds((const unsigned*)((const char*)(gbase) + (voff)[_i]), (LAS unsigned*)(lds + (bufoff) + ldsw + _i * 8192), 16, 0, 0); } while (0)
#define PG8_LDA(dst, b, h) do { _Pragma("unroll") for (int m = 0; m < 4; ++m) _Pragma("unroll") for (int k = 0; k < 2; ++k) dst[m][k] = *(const LAS bf16x8*)(lds + PG8_SA(b, h) + aoff + m * 2048 + k * 1024); } while (0)
#define PG8_LDB(dst, b, h) do { _Pragma("unroll") for (int n = 0; n < 2; ++n) _Pragma("unroll") for (int k = 0; k < 2; ++k) dst[n][k] = *(const LAS bf16x8*)(lds + PG8_SB(b, h) + boff + n * 2048 + k * 1024); } while (0)
#define PG8_MMA(ai, bj, At, Bt) do { __builtin_amdgcn_s_setprio(1); _Pragma("unroll") for (int m = 0; m < 4; ++m) _Pragma("unroll") for (int n = 0; n < 2; ++n) _Pragma("unroll") for (int k = 0; k < 2; ++k) \
        acc[ai][bj][m][n] = __builtin_amdgcn_mfma_f32_16x16x32_bf16(Bt[n][k], At[m][k], acc[ai][bj][m][n], 0, 0, 0); __builtin_amdgcn_s_setprio(0); } while (0)
#define PG8_WAIT_V(n) asm volatile("s_waitcnt vmcnt(" #n ")" ::: "memory")
#define PG8_WAIT_L(n) asm volatile("s_waitcnt lgkmcnt(" #n ")" ::: "memory")
#define PG8_BAR __builtin_amdgcn_s_barrier()
#define PG8_SCHED __builtin_amdgcn_sched_barrier(0)
    Unit cur, nxt; int ui = 0;
    if (!S.next(0, cur)) return;
    f32x4 acc[2][2][4][2];
#pragma unroll
    for (int a = 0; a < 2; ++a)
#pragma unroll
        for (int b = 0; b < 2; ++b)
#pragma unroll
            for (int m = 0; m < 4; ++m)
#pragma unroll
                for (int n = 0; n < 2; ++n) acc[a][b][m][n] = (f32x4){0.f, 0.f, 0.f, 0.f};
    bf16x8 At[4][2], B0[2][2], B1[2][2];
    PG8_STAGE(PG8_SB(0, 0), cur.b0, voffB); PG8_STAGE(PG8_SB(0, 1), cur.b1, voffB); PG8_STAGE(PG8_SA(0, 0), cur.a, voffA); PG8_STAGE(PG8_SA(0, 1), cur.a + hstepA, voffA);
    if (wr == 1) PG8_BAR;
    PG8_WAIT_V(2); PG8_BAR;
    PG8_STAGE(PG8_SB(1, 0), cur.b0 + kstep, voffB); PG8_STAGE(PG8_SA(1, 0), cur.a + kstep, voffA); PG8_STAGE(PG8_SB(1, 1), cur.b1 + kstep, voffB);
    PG8_WAIT_V(6); PG8_BAR;
    for (;;) {
        const bool has_next = S.next(ui + 1, nxt);
        const char* nA = has_next ? nxt.a : cur.a; const char* nB0 = has_next ? nxt.b0 : cur.b0; const char* nB1 = has_next ? nxt.b1 : cur.b1;
        for (int t = 0; t < nt; t += 2) {
            const bool last = (t == nt - 2);
            const char* a1 = cur.a + (size_t)(t + 1) * kstep;
            const char* a2 = last ? nA : cur.a + (size_t)(t + 2) * kstep;
            const char* b2_0 = last ? nB0 : cur.b0 + (size_t)(t + 2) * kstep; const char* b2_1 = last ? nB1 : cur.b1 + (size_t)(t + 2) * kstep;
            const char* a3 = a2 + kstep; const char* b3_0 = b2_0 + kstep; const char* b3_1 = b2_1 + kstep;
            PG8_LDB(B0, 0, 0); PG8_LDB(B1, 0, 1); PG8_SCHED; PG8_LDA(At, 0, 0); PG8_STAGE(PG8_SA(1, 1), a1 + hstepA, voffA);
            PG8_WAIT_V(8); PG8_WAIT_L(0); PG8_BAR; PG8_MMA(0, 0, At, B0); PG8_MMA(0, 1, At, B1); PG8_BAR; PG8_SCHED;
            PG8_LDA(At, 0, 1); PG8_STAGE(PG8_SB(0, 0), b2_0, voffB); PG8_STAGE(PG8_SB(0, 1), b2_1, voffB); PG8_STAGE(PG8_SA(0, 0), a2, voffA);
            PG8_WAIT_V(8); PG8_WAIT_L(0); PG8_BAR; PG8_MMA(1, 0, At, B0); PG8_MMA(1, 1, At, B1); PG8_BAR; PG8_SCHED;
            PG8_LDB(B0, 1, 0); PG8_LDB(B1, 1, 1); PG8_SCHED; PG8_LDA(At, 1, 0); PG8_STAGE(PG8_SA(0, 1), a2 + hstepA, voffA);
            PG8_WAIT_V(8); PG8_WAIT_L(0); PG8_BAR; PG8_MMA(0, 0, At, B0); PG8_MMA(0, 1, At, B1); PG8_BAR; PG8_SCHED;
            PG8_LDA(At, 1, 1); PG8_STAGE(PG8_SB(1, 0), b3_0, voffB); PG8_STAGE(PG8_SB(1, 1), b3_1, voffB); PG8_STAGE(PG8_SA(1, 0), a3, voffA);
            PG8_WAIT_V(8); PG8_WAIT_L(0); PG8_BAR; PG8_MMA(1, 0, At, B0); PG8_MMA(1, 1, At, B1); PG8_BAR; PG8_SCHED;
        }
        if (wr == 0) PG8_BAR;
        E(acc, cur, wr, wc, fr, fq);
        if (!has_next) break;
#pragma unroll
        for (int a = 0; a < 2; ++a)
#pragma unroll
            for (int b = 0; b < 2; ++b)
#pragma unroll
                for (int m = 0; m < 4; ++m)
#pragma unroll
                    for (int n = 0; n < 2; ++n) acc[a][b][m][n] = (f32x4){0.f, 0.f, 0.f, 0.f};
        cur = nxt; ++ui;
        if (wr == 1) PG8_BAR;
    }
    PG8_WAIT_V(0);
    PG8_BAR;
#undef PG8_SA
#undef PG8_SB
#undef PG8_STAGE
#undef PG8_LDA
#undef PG8_LDB
#undef PG8_MMA
#undef PG8_WAIT_V
#undef PG8_WAIT_L
#undef PG8_BAR
#undef PG8_SCHED
}
}

namespace pg8 {
struct SchedPlain {
    TileOrder T; const char* A; const char* Bt; size_t tstepA, tstepB, hstepB;
    __device__ __forceinline__ void init(const bf16* A_, int lda, const bf16* Bt_, int ldb, int M, int N, int G, int c) {
        T.init(M / BM, N / BM, G, c); A = (const char*)A_; Bt = (const char*)Bt_; tstepA = (size_t)BM * lda * 2; tstepB = (size_t)BM * ldb * 2; hstepB = (size_t)HALF * ldb * 2; }
    __device__ __forceinline__ bool next(int i, Unit& u) const {
        int pm, pn; if (!T.map(i, pm, pn)) return false;
        u.pm = pm; u.pn = pn; u.kind = 0; u.aux = 0; u.a = A + (size_t)pm * tstepA; u.b0 = Bt + (size_t)pn * tstepB; u.b1 = u.b0 + hstepB; return true; }
};
struct SchedTwoSeg {
    TileOrder T; const char* A0; const char* A1; const char* B0t; const char* B1t; size_t tstepA, tstepB, hstepB;
    __device__ __forceinline__ void init(const bf16* A0_, const bf16* A1_, int lda, const bf16* B0_, const bf16* B1_, int ldb, int M, int N, int G, int c) {
        T.init(M / BM, N / BM, G, c); A0 = (const char*)A0_; A1 = (const char*)A1_; B0t = (const char*)B0_; B1t = (const char*)B1_; tstepA = (size_t)BM * lda * 2; tstepB = (size_t)BM * ldb * 2; hstepB = (size_t)HALF * ldb * 2; }
    __device__ __forceinline__ bool next(int i, Unit& u) const {
        int pm, pn; if (!T.map(i >> 1, pm, pn)) return false;
        const int seg = i & 1; u.pm = pm; u.pn = pn; u.kind = seg; u.aux = 0;
        u.a = (seg ? A1 : A0) + (size_t)pm * tstepA; u.b0 = (seg ? B1t : B0t) + (size_t)pn * tstepB; u.b1 = u.b0 + hstepB; return true; }
};
struct SchedMoe {
    TileOrder T; const char* A; const char* Bt; size_t tstepA, tstepB, hstepB, estepB; const volatile LAS int* pp;
    __device__ __forceinline__ void init(const bf16* A_, int lda, const bf16* Bt_, int ldb, int N, const volatile LAS int* pp_, int G, int c) {
        pp = pp_; const int np = pp[NE]; T.init(np, N / BM, G, c); A = (const char*)A_; Bt = (const char*)Bt_;
        tstepA = (size_t)BM * lda * 2; tstepB = (size_t)BM * ldb * 2; hstepB = (size_t)HALF * ldb * 2; estepB = (size_t)N * ldb * 2; }
    __device__ __forceinline__ bool next(int i, Unit& u) const {
        int pm, pn; if (!T.map(i, pm, pn)) return false;
        int e = 0;
#pragma unroll
        for (int j = 1; j < NE; ++j) e += (pm >= pp[j]) ? 1 : 0;
        u.pm = pm; u.pn = pn; u.kind = 0; u.aux = e; u.a = A + (size_t)pm * tstepA; u.b0 = Bt + (size_t)e * estepB + (size_t)pn * tstepB; u.b1 = u.b0 + hstepB; return true; }
};

typedef const f32x4 (&AccRef)[2][2][4][2];
struct EpiProj {
    static constexpr bool PERM = true;
    bf16* P; const float* bgate;
    __device__ __forceinline__ void operator()(AccRef acc, const Unit& u, int wr, int wc, int fr, int fq) const {
        const int row0 = u.pm * BM + wr * 64 + fr, col0 = u.pn * BM + wc * 32 + 8 * fq;
        const int mode = u.pn < 4 ? 0 : (u.pn < 12 ? 1 : (u.pn < 20 ? 2 : 3));
        f32x4 bv[2][2];
#pragma unroll
        for (int bj = 0; bj < 2; ++bj)
#pragma unroll
            for (int n = 0; n < 2; ++n) bv[bj][n] = (mode == 3) ? *(const f32x4*)(bgate + (col0 - OFF_GATE) + bj * HALF + 4 * n) : (f32x4){0.f, 0.f, 0.f, 0.f};
#pragma unroll
        for (int ai = 0; ai < 2; ++ai)
#pragma unroll
            for (int m = 0; m < 4; ++m) { bf16* rowp = P + (size_t)(row0 + ai * HALF + m * 16) * DIN + col0;
#pragma unroll
                for (int bj = 0; bj < 2; ++bj) { f32x4 v0 = acc[ai][bj][m][0], v1 = acc[ai][bj][m][1];
                    if (mode == 0) { v0 = v0 * QSCALE; v1 = v1 * QSCALE; }
                    else if (mode == 2) {
#pragma unroll
                        for (int j = 0; j < 4; ++j) { v0[j] = gelu_tanh_f(v0[j]); v1[j] = gelu_tanh_f(v1[j]); } }
                    else if (mode == 3) { v0 = v0 + bv[bj][0]; v1 = v1 + bv[bj][1];
#pragma unroll
                        for (int j = 0; j < 4; ++j) { v0[j] = sigmoid_f(v0[j]); v1[j] = sigmoid_f(v1[j]); } }
                    u32x4 w; w.x = cvt_pk_bf16(v0[0], v0[1]); w.y = cvt_pk_bf16(v0[2], v0[3]); w.z = cvt_pk_bf16(v1[0], v1[1]); w.w = cvt_pk_bf16(v1[2], v1[3]);
                    *(u32x4*)(rowp + bj * HALF) = w; } }
    }
};
__device__ __forceinline__ f32x4 bf4_to_f32(u32x2 w) { f32x4 r; r[0] = __builtin_bit_cast(float, w.x << 16); r[1] = __builtin_bit_cast(float, w.x & 0xffff0000u); r[2] = __builtin_bit_cast(float, w.y << 16); r[3] = __builtin_bit_cast(float, w.y & 0xffff0000u); return r; }
struct EpiBranch {
    static constexpr bool PERM = false;
    float* T; bf16* MG; const bf16* P;
    __device__ __forceinline__ void operator()(AccRef acc, const Unit& u, int wr, int wc, int fr, int fq) const {
        const int row0 = u.pm * BM + wr * 64 + fr, col0 = u.pn * BM + wc * 32 + 4 * fq;
        const int goff = OFF_GATE + (u.kind ? D : 0);
#pragma unroll
        for (int ai = 0; ai < 2; ++ai)
#pragma unroll
            for (int m = 0; m < 4; ++m) { const size_t row = (size_t)(row0 + ai * HALF + m * 16);
#pragma unroll
                for (int bj = 0; bj < 2; ++bj)
#pragma unroll
                    for (int n = 0; n < 2; ++n) { const int col = col0 + bj * HALF + n * 16;
                        const f32x4 g = bf4_to_f32(*(const u32x2*)(P + row * DIN + goff + col));
                        if (u.kind == 0) { *(f32x4*)(T + row * D + col) = g * acc[ai][bj][m][n]; }
                        else { const f32x4 t = *(const f32x4*)(T + row * D + col); const f32x4 o = t + g * acc[ai][bj][m][n];
                            u32x2 w; w.x = cvt_pk_bf16(o[0], o[1]); w.y = cvt_pk_bf16(o[2], o[3]); *(u32x2*)(MG + row * D + col) = w; } } }
    }
};
struct EpiResid {
    static constexpr bool PERM = false;
    float* Y; const float* X;
    __device__ __forceinline__ void operator()(AccRef acc, const Unit& u, int wr, int wc, int fr, int fq) const {
        const int row0 = u.pm * BM + wr * 64 + fr, col0 = u.pn * BM + wc * 32 + 4 * fq;
#pragma unroll
        for (int ai = 0; ai < 2; ++ai)
#pragma unroll
            for (int m = 0; m < 4; ++m) { const size_t off = (size_t)(row0 + ai * HALF + m * 16) * D + col0;
#pragma unroll
                for (int bj = 0; bj < 2; ++bj)
#pragma unroll
                    for (int n = 0; n < 2; ++n) { f32x4 o = acc[ai][bj][m][n];
                        if (X) { const f32x4 x = *(const f32x4*)(X + off + bj * HALF + n * 16); o = o + x * ALPHA; }
                        *(f32x4*)(Y + off + bj * HALF + n * 16) = o; } }
    }
};
struct EpiSwiGlu {
    static constexpr bool PERM = true;
    bf16* H; long ldh;
    __device__ __forceinline__ void operator()(AccRef acc, const Unit& u, int wr, int wc, int fr, int fq) const {
        const int row0 = u.pm * BM + wr * 64 + fr, col0 = u.pn * HALF + wc * 32 + 8 * fq;
#pragma unroll
        for (int ai = 0; ai < 2; ++ai)
#pragma unroll
            for (int m = 0; m < 4; ++m) { bf16* rowp = H + (size_t)(row0 + ai * HALF + m * 16) * ldh + col0;
                f32x4 o[2];
#pragma unroll
                for (int n = 0; n < 2; ++n) { const f32x4 a = acc[ai][0][m][n], b = acc[ai][1][m][n];
#pragma unroll
                    for (int j = 0; j < 4; ++j) o[n][j] = a[j] * sigmoid_f(a[j]) * b[j]; }
                u32x4 w; w.x = cvt_pk_bf16(o[0][0], o[0][1]); w.y = cvt_pk_bf16(o[0][2], o[0][3]); w.z = cvt_pk_bf16(o[1][0], o[1][1]); w.w = cvt_pk_bf16(o[1][2], o[1][3]);
                *(u32x4*)rowp = w; }
    }
};
}

struct Frame {
    LAS unsigned char* lds;
    volatile LAS unsigned* MISC;
    gu32* ctl;
    int tid, lane, wave, vcu, G;
};
__device__ __forceinline__ float wave_sum(float v) {
#pragma unroll
    for (int o = 1; o < 64; o <<= 1) v += __shfl_xor(v, o);
    return v;
}
__device__ __forceinline__ void cvt_tile(const float* __restrict__ W, int ldw, bf16* __restrict__ WT, int ldt, int k0, int n0, int rs, int ro, LAS unsigned char* scr, int lane) {
    const int kq = lane & 3, nq = lane >> 2;
    const float* src = W + (size_t)(k0 + kq) * ldw + n0 + 4 * nq;
    f32x4 v[16];
#pragma unroll
    for (int j = 0; j < 16; ++j) v[j] = *(const f32x4*)(src + (size_t)(4 * j) * ldw);
#pragma unroll
    for (int j = 0; j < 16; ++j) {
        const int k = 4 * j + kq;
        const unsigned w01 = cvt_pk_bf16(v[j][0], v[j][1]), w23 = cvt_pk_bf16(v[j][2], v[j][3]);
        const int cb = (((k >> 3) ^ (nq & 7)) << 4) | ((k & 7) << 1);
        LAS unsigned char* p = scr + (4 * nq) * 128 + cb;
        *(LAS unsigned short*)(p) = (unsigned short)(w01 & 0xffffu);
        *(LAS unsigned short*)(p + 128) = (unsigned short)(w01 >> 16);
        *(LAS unsigned short*)(p + 256) = (unsigned short)(w23 & 0xffffu);
        *(LAS unsigned short*)(p + 384) = (unsigned short)(w23 >> 16);
    }
    LDS_WAIT(); asm volatile("" ::: "memory");
    const int c = lane & 7;
#pragma unroll
    for (int r = 0; r < 8; ++r) {
        const int n = (lane >> 3) + 8 * r;
        const u32x4 o = *(const LAS u32x4*)(scr + n * 128 + ((c ^ ((n >> 2) & 7)) << 4));
        const int ng = n0 + n, drow = (ng >> 7) * rs + (ng & 127) + ro;
        *(u32x4*)(WT + (size_t)drow * ldt + k0 + 8 * c) = o;
    }
    LDS_WAIT(); asm volatile("" ::: "memory");
}
struct CvtSeg { const float* W; bf16* WT; int K, N, rs, ro; };
__device__ __forceinline__ void p0_convert(Frame& F, const Params& p) {
    unsigned char* ws = p.ws;
    LAS unsigned char* scr = F.lds + F.wave * 8192;
    const int gw = F.vcu * NWAVES + F.wave, NGW = F.G * NWAVES;
    constexpr int NSEG = 2 + 2 + 2 + 2 + 3 + 3;
    for (int sgi = 0; sgi < NSEG; ++sgi) {
        const float* W; bf16* WT; int K, N, rs = 128, ro = 0, reps = 1; size_t wstep = 0, tstep = 0;
        if (sgi < 2)       { W = p.in[1] + (size_t)sgi * D * DIN; WT = (bf16*)(ws + WS_WIN) + (size_t)sgi * DIN * D; K = D; N = DIN; }
        else if (sgi < 4)  { W = p.in[7] + (size_t)(sgi - 2) * SBW * D; WT = (bf16*)(ws + WS_WA) + (size_t)(sgi - 2) * D * SBW; K = SBW; N = D; }
        else if (sgi < 6)  { W = p.in[8] + (size_t)(sgi - 4) * SBW * D; WT = (bf16*)(ws + WS_WB) + (size_t)(sgi - 4) * D * SBW; K = SBW; N = D; }
        else if (sgi < 8)  { W = p.in[9] + (size_t)(sgi - 6) * D * D; WT = (bf16*)(ws + WS_WOUT) + (size_t)(sgi - 6) * D * D; K = D; N = D; }
        else if (sgi == 8) { W = p.in[12]; WT = (bf16*)(ws + WS_W13D); K = D; N = FF_D; rs = 256; ro = 0; }
        else if (sgi == 9) { W = p.in[13]; WT = (bf16*)(ws + WS_W13D); K = D; N = FF_D; rs = 256; ro = 128; }
        else if (sgi == 10){ W = p.in[14]; WT = (bf16*)(ws + WS_W2D); K = FF_D; N = D; }
        else if (sgi == 11){ W = p.in[16]; WT = (bf16*)(ws + WS_W13E); K = D; N = FF_E; rs = 256; ro = 0; reps = NE; wstep = (size_t)D * FF_E; tstep = (size_t)2 * FF_E * D; }
        else if (sgi == 12){ W = p.in[17]; WT = (bf16*)(ws + WS_W13E); K = D; N = FF_E; rs = 256; ro = 128; reps = NE; wstep = (size_t)D * FF_E; tstep = (size_t)2 * FF_E * D; }
        else               { W = p.in[18]; WT = (bf16*)(ws + WS_W2E); K = FF_E; N = D; reps = NE; wstep = (size_t)FF_E * D; tstep = (size_t)D * FF_E; }
        const int ntn = N / 64, ntk = K / 64, per = ntn * ntk, tot = per * reps;
        for (int it = gw; it < tot; it += NGW) {
            const int rep = it / per, r = it - rep * per, kt = r / ntn, nti = r - kt * ntn;
            cvt_tile(W + (size_t)rep * wstep, N, WT + (size_t)rep * tstep, K, kt * 64, nti * 64, rs, ro, scr, F.lane);
        }
    }
    { const f32x4* x = (const f32x4*)p.in[0]; u32x2* o = (u32x2*)(ws + WS_XB); const size_t n4 = (size_t)S * D / 4;
        for (size_t i = (size_t)blockIdx.x * NTHREADS + F.tid; i < n4; i += (size_t)F.G * NTHREADS) { const f32x4 v = x[i]; u32x2 w; w.x = cvt_pk_bf16(v[0], v[1]); w.y = cvt_pk_bf16(v[2], v[3]); o[i] = w; } }
}

namespace att {
#define KSWZ(row, colB) ((row) * 256 + ((colB) ^ (((row) & 7) << 4)))
__device__ __forceinline__ int crow(int r, int hi) { return (r & 3) + 8 * (r >> 2) + 4 * hi; }
__device__ __forceinline__ int v_st(int k, int c) { const int kk = (k & ~0xC) | ((k & 4) << 1) | ((k & 8) >> 1); return ((kk >> 3) * 4 + (c >> 5)) * 512 + ((kk & 7) * 32 + (c & 31)) * 2; }
__device__ __forceinline__ int v_rd_base(int lane) { return ((lane & 3) << 3) | (((lane >> 2) & 3) << 6) | (((lane >> 4) & 1) << 5) | (((lane >> 5) & 1) << 8); }
constexpr int v_rd_off(int d0, int ks, int half) { return d0 * 512 + ks * 4096 + half * 2048; }
template <int OFF> __device__ __forceinline__ s16x4 tr_read(int vb) {
    s16x4 r; asm volatile("ds_read_b64_tr_b16 %0, %1 offset:%2" : "=&v"(r) : "v"(vb), "i"(OFF) : "memory"); return r;
}
template <int D0> __device__ __forceinline__ void pv_one(f32x16& od, int vb, bf16x8 pa0, bf16x8 pa1, bf16x8 pa2, bf16x8 pa3) {
    const s16x4 l0 = tr_read<v_rd_off(D0, 0, 0)>(vb), h0 = tr_read<v_rd_off(D0, 0, 1)>(vb), l1 = tr_read<v_rd_off(D0, 1, 0)>(vb), h1 = tr_read<v_rd_off(D0, 1, 1)>(vb);
    const s16x4 l2 = tr_read<v_rd_off(D0, 2, 0)>(vb), h2 = tr_read<v_rd_off(D0, 2, 1)>(vb), l3 = tr_read<v_rd_off(D0, 3, 0)>(vb), h3 = tr_read<v_rd_off(D0, 3, 1)>(vb);
    asm volatile("s_waitcnt lgkmcnt(0)" ::: "memory"); SBAR();
#define PK(L, H) (bf16x8){L[0], L[1], L[2], L[3], H[0], H[1], H[2], H[3]}
    od = __builtin_amdgcn_mfma_f32_32x32x16_bf16(pa0, PK(l0, h0), od, 0, 0, 0);
    od = __builtin_amdgcn_mfma_f32_32x32x16_bf16(pa1, PK(l1, h1), od, 0, 0, 0);
    od = __builtin_amdgcn_mfma_f32_32x32x16_bf16(pa2, PK(l2, h2), od, 0, 0, 0);
    od = __builtin_amdgcn_mfma_f32_32x32x16_bf16(pa3, PK(l3, h3), od, 0, 0, 0);
#undef PK
}
__device__ __forceinline__ void qkt(f32x16& p0, f32x16& p1, const LAS unsigned char* Ks, const bf16x8* qr, int r32, int hi) {
    p0 = f32x16{}; p1 = f32x16{};
#pragma unroll
    for (int d0 = 0; d0 < 8; ++d0) { const int cb = (d0 * 16 + hi * 8) * 2;
        const bf16x8 b0 = *(const LAS bf16x8*)(Ks + KSWZ(r32, cb));
        const bf16x8 b1 = *(const LAS bf16x8*)(Ks + KSWZ(32 + r32, cb));
        p0 = __builtin_amdgcn_mfma_f32_32x32x16_bf16(b0, qr[d0], p0, 0, 0, 0);
        p1 = __builtin_amdgcn_mfma_f32_32x32x16_bf16(b1, qr[d0], p1, 0, 0, 0); }
}
__device__ __forceinline__ void stick_tile(f32x16& p0, f32x16& p1, float& Rm, int hi, bf16x8& pa0, bf16x8& pa1, bf16x8& pa2, bf16x8& pa3) {
    float I[8][4];
#pragma unroll
    for (int g = 0; g < 8; ++g) {
#pragma unroll
        for (int e = 3; e >= 0; --e) {
            const float z = (g < 4) ? p0[4 * g + e] : p1[4 * (g - 4) + e];
            const float sp = fast_log2(1.f + fast_exp2(fminf(z, 126.f)));
            I[g][e] = (e == 3) ? sp : I[g][e + 1] + sp;
        }
    }
    float IS[9];
    IS[8] = hi ? 0.f : Rm;
#pragma unroll
    for (int g = 7; g >= 0; --g) IS[g] = IS[g + 1] + I[g][0];
    float TB[8];
#pragma unroll
    for (int g = 0; g < 8; ++g) {
        const auto rr = __builtin_amdgcn_permlane32_swap(__float_as_uint(IS[g]), __float_as_uint(IS[g + 1]), false, false);
        const float sel = hi ? __uint_as_float(rr[0]) : __uint_as_float(rr[1]);
        TB[g] = IS[g + 1] + sel;
    }
    { const auto rr = __builtin_amdgcn_permlane32_swap(__float_as_uint(IS[0]), __float_as_uint(IS[0]), false, false);
      const float other = hi ? __uint_as_float(rr[0]) : __uint_as_float(rr[1]);
      Rm = IS[0] + other; }
#pragma unroll
    for (int g = 0; g < 8; ++g)
#pragma unroll
        for (int e = 0; e < 4; ++e) {
            const float z = (g < 4) ? p0[4 * g + e] : p1[4 * (g - 4) + e];
            const float a = fast_exp2(z - (TB[g] + I[g][e]));
            if (g < 4) p0[4 * g + e] = a; else p1[4 * (g - 4) + e] = a;
        }
#define PK4(P, BASE, OUT) do { unsigned a0 = cvt_pk_bf16(P[BASE + 0], P[BASE + 1]), a1 = cvt_pk_bf16(P[BASE + 2], P[BASE + 3]);   \
    unsigned b0 = cvt_pk_bf16(P[BASE + 4], P[BASE + 5]), b1 = cvt_pk_bf16(P[BASE + 6], P[BASE + 7]);                              \
    auto r0 = __builtin_amdgcn_permlane32_swap(a0, b0, false, false); auto r1 = __builtin_amdgcn_permlane32_swap(a1, b1, false, false); \
    u32x4 w = {r0[0], r1[0], r0[1], r1[1]}; OUT = __builtin_bit_cast(bf16x8, w); } while (0)
    PK4(p0, 0, pa0); PK4(p0, 8, pa1); PK4(p1, 0, pa2); PK4(p1, 8, pa3);
#undef PK4
}
constexpr int SHM_V = 16384, SHM_K = 16384;
__device__ __forceinline__ void attn_unit(const bf16* __restrict__ P, bf16* __restrict__ AO, int h, int qb, LAS unsigned char* lds, int tid, int wid, int lane) {
    const int r32 = lane & 31, hi = lane >> 5;
    LAS unsigned char* V_lds = lds; LAS unsigned char* K_lds = lds + 2 * SHM_V;
    const int t0 = qb * 256 + wid * 32;
    bf16x8 qr[8];
    { const bf16* Qw = P + (size_t)(t0 + r32) * DIN + OFF_Q + h * HD + hi * 8;
#pragma unroll
      for (int d0 = 0; d0 < 8; ++d0) qr[d0] = *(const bf16x8*)(Qw + d0 * 16); }
    const int sr = tid >> 4, sc = (tid & 15) * 8, vst0 = v_st(sr, sc), vst1 = v_st(32 + sr, sc);
    const int vb0 = (int)(unsigned)(uintptr_t)V_lds + v_rd_base(lane);
    const bf16* Kg = P + OFF_K + h * HD + sc; const bf16* Vg = P + OFF_V + h * HD + sc;
    bf16x8 vs0, vs1, ks0, ks1;
#define SLOAD(k0) do { vs0 = *(const bf16x8*)(Vg + (size_t)((k0) + sr) * DIN); vs1 = *(const bf16x8*)(Vg + (size_t)((k0) + 32 + sr) * DIN); \
    ks0 = *(const bf16x8*)(Kg + (size_t)((k0) + sr) * DIN); ks1 = *(const bf16x8*)(Kg + (size_t)((k0) + 32 + sr) * DIN); } while (0)
#define SWRITE(b) do { *(LAS bf16x8*)(V_lds + (b) * SHM_V + vst0) = vs0; *(LAS bf16x8*)(V_lds + (b) * SHM_V + vst1) = vs1; const int kc = sc * 2; \
    *(LAS bf16x8*)(K_lds + (b) * SHM_K + KSWZ(sr, kc)) = ks0; *(LAS bf16x8*)(K_lds + (b) * SHM_K + KSWZ(32 + sr, kc)) = ks1; } while (0)
    f32x16 o[4] = {};
    float Rm = 0.f; bool wdone = false;
    volatile LAS unsigned* flg = (volatile LAS unsigned*)(lds + 2 * SHM_V + 2 * SHM_K);
    const int jtop = 4 * qb + 3, jw = 4 * qb + (wid >> 1);
    SLOAD(jtop * 64); VM_WAIT(); SWRITE(0); __syncthreads();
    for (int j = jtop; j >= 0; --j) {
        const int buf = (jtop - j) & 1;
        if (j > 0) SLOAD((j - 1) * 64);
        if (j <= jw) {
            f32x16 p0, p1;
            qkt(p0, p1, K_lds + buf * SHM_K, qr, r32, hi);
            if (j == jw) {
                const int t = t0 + r32, kb = j * 64;
#pragma unroll
                for (int r = 0; r < 16; ++r) { if (kb + crow(r, hi) >= t) p0[r] = -1e30f; if (kb + 32 + crow(r, hi) >= t) p1[r] = -1e30f; }
            }
            bf16x8 pa0, pa1, pa2, pa3;
            stick_tile(p0, p1, Rm, hi, pa0, pa1, pa2, pa3);
            wdone = __all(Rm > 152.f);
            const int vb = vb0 + buf * SHM_V;
            pv_one<0>(o[0], vb, pa0, pa1, pa2, pa3); pv_one<1>(o[1], vb, pa0, pa1, pa2, pa3); pv_one<2>(o[2], vb, pa0, pa1, pa2, pa3); pv_one<3>(o[3], vb, pa0, pa1, pa2, pa3);
        }
        if (j > 0) { VM_WAIT(); SWRITE(buf ^ 1); }
        if (lane == 0) flg[(j & 1) * 8 + wid] = (j <= jw && wdone) ? 1u : 0u;
        __syncthreads();
        { unsigned all = 1u;
#pragma unroll
          for (int w = 0; w < NWAVES; ++w) all &= flg[(j & 1) * 8 + w];
          if (all) break; }
    }
    bf16* Ow = AO + (size_t)t0 * SBW + h * HD;
#pragma unroll
    for (int r = 0; r < 16; ++r) { const int orow = crow(r, hi);
#pragma unroll
        for (int d0 = 0; d0 < 4; ++d0) Ow[(size_t)orow * SBW + d0 * 32 + r32] = f2bf(o[d0][r]); }
#undef SLOAD
#undef SWRITE
}
__device__ __forceinline__ void sgu_unit(const bf16* __restrict__ P, bf16* __restrict__ SO, const float* __restrict__ sgw, const float* __restrict__ sgb, const float* __restrict__ lng, const float* __restrict__ lnb,
                                         int c, int g, LAS unsigned char* lds, int tid, int wid, int lane) {
    const int r32 = lane & 31, hi = lane >> 5;
    {
        const int s = tid >> 2, qd = tid & 3;
        const bf16* src = P + (size_t)(c * 128 + s) * DIN + OFF_VG + g * 128 + qd * 32;
        float x[32];
#pragma unroll
        for (int i = 0; i < 4; ++i) { const u32x4 w = *(const u32x4*)(src + 8 * i);
#pragma unroll
            for (int j = 0; j < 4; ++j) { x[8 * i + 2 * j] = __builtin_bit_cast(float, w[j] << 16); x[8 * i + 2 * j + 1] = __builtin_bit_cast(float, w[j] & 0xffff0000u); } }
        float sm = 0.f;
#pragma unroll
        for (int i = 0; i < 32; ++i) sm += x[i];
        sm += __shfl_xor(sm, 1); sm += __shfl_xor(sm, 2);
        const float mu = sm * (1.f / 128.f);
        float q = 0.f;
#pragma unroll
        for (int i = 0; i < 32; ++i) { x[i] -= mu; q += x[i] * x[i]; }
        q += __shfl_xor(q, 1); q += __shfl_xor(q, 2);
        const float rstd = rsqrtf(q * (1.f / 128.f) + LN_EPS);
        const float* gg = lng + g * 128 + qd * 32; const float* bb = lnb + g * 128 + qd * 32;
#pragma unroll
        for (int i = 0; i < 4; ++i) { u32x4 w;
#pragma unroll
            for (int j = 0; j < 4; ++j) { const int ch = 8 * i + 2 * j; w[j] = cvt_pk_bf16(x[ch] * rstd * gg[ch] + bb[ch], x[ch + 1] * rstd * gg[ch + 1] + bb[ch + 1]); }
            *(LAS u32x4*)(lds + (s >> 6) * SHM_V + v_st(s & 63, qd * 32 + 8 * i)) = w; }
    }
    __syncthreads();
    const int tb = wid >> 1, dh = wid & 1;
    f32x16 o[2] = {};
    const int vb0 = (int)(unsigned)(uintptr_t)lds + v_rd_base(lane);
    const int t = 32 * tb + r32;
    const float* wrow = sgw + ((size_t)g * 128 + t) * 128;
#pragma unroll
    for (int kt = 0; kt < 2; ++kt) {
        if (64 * kt <= 32 * tb + 31) {
            bf16x8 pa[4];
#pragma unroll
            for (int ks = 0; ks < 4; ++ks) { const int s0 = 64 * kt + 16 * ks + 8 * hi;
                const f32x4 w0 = *(const f32x4*)(wrow + s0), w1 = *(const f32x4*)(wrow + s0 + 4);
                u32x4 w; w.x = cvt_pk_bf16(s0 + 0 <= t ? w0[0] : 0.f, s0 + 1 <= t ? w0[1] : 0.f); w.y = cvt_pk_bf16(s0 + 2 <= t ? w0[2] : 0.f, s0 + 3 <= t ? w0[3] : 0.f);
                w.z = cvt_pk_bf16(s0 + 4 <= t ? w1[0] : 0.f, s0 + 5 <= t ? w1[1] : 0.f); w.w = cvt_pk_bf16(s0 + 6 <= t ? w1[2] : 0.f, s0 + 7 <= t ? w1[3] : 0.f);
                pa[ks] = __builtin_bit_cast(bf16x8, w); }
            const int vb = vb0 + kt * SHM_V;
            if (dh == 0) { pv_one<0>(o[0], vb, pa[0], pa[1], pa[2], pa[3]); pv_one<1>(o[1], vb, pa[0], pa[1], pa[2], pa[3]); }
            else         { pv_one<2>(o[0], vb, pa[0], pa[1], pa[2], pa[3]); pv_one<3>(o[1], vb, pa[0], pa[1], pa[2], pa[3]); }
        }
    }
#pragma unroll
    for (int r = 0; r < 16; ++r) { const int tt = 32 * tb + crow(r, hi); const float bt = sgb[g * 128 + tt]; const size_t row = (size_t)(c * 128 + tt);
#pragma unroll
        for (int i = 0; i < 2; ++i) { const int d = 64 * dh + 32 * i + r32;
            const float u = bf2f(P[row * DIN + OFF_U + g * 128 + d]);
            SO[row * SBW + g * 128 + d] = f2bf(u * (o[i][r] + bt)); } }
    __syncthreads();
}
}

template <int MODE, bool ROUTE>
__device__ __forceinline__ void ln_phase(Frame& F, const float* __restrict__ Y, const float* __restrict__ X1, const float* __restrict__ YS, const int* __restrict__ tinfo, const float* __restrict__ tw,
                                         const float* __restrict__ g, const float* __restrict__ b, float* __restrict__ XF, bf16* __restrict__ XBo, const float* __restrict__ Wr, int* cnt, int* tinfo_o, float* tw_o) {
    const int gw = F.vcu * NWAVES + F.wave, NGW = F.G * NWAVES, lane = F.lane;
    for (int row = gw; row < S; row += NGW) {
        f32x4 v[8];
        if (MODE == 1) {
            const int e0 = tinfo[row * 4 + 0], p0 = tinfo[row * 4 + 1], e1 = tinfo[row * 4 + 2], p1 = tinfo[row * 4 + 3];
            const int r0 = 256 * (int)F.MISC[16 + e0] + p0, r1 = 256 * (int)F.MISC[16 + e1] + p1;
            const float w0 = tw[row * 2], w1 = tw[row * 2 + 1];
            const f32x4* x = (const f32x4*)(X1 + (size_t)row * D); const f32x4* y0 = (const f32x4*)(YS + (size_t)r0 * D); const f32x4* y1 = (const f32x4*)(YS + (size_t)r1 * D);
#pragma unroll
            for (int j = 0; j < 8; ++j) v[j] = x[lane + 64 * j] * ALPHA + (y0[lane + 64 * j] * w0 + y1[lane + 64 * j] * w1);
        } else {
            const f32x4* y = (const f32x4*)(Y + (size_t)row * D);
#pragma unroll
            for (int j = 0; j < 8; ++j) v[j] = y[lane + 64 * j];
        }
        float s = 0.f;
#pragma unroll
        for (int j = 0; j < 8; ++j) s += (v[j][0] + v[j][1]) + (v[j][2] + v[j][3]);
        const float mu = wave_sum(s) * (1.f / D);
        float q = 0.f;
#pragma unroll
        for (int j = 0; j < 8; ++j) { v[j] = v[j] - mu; q += (v[j][0] * v[j][0] + v[j][1] * v[j][1]) + (v[j][2] * v[j][2] + v[j][3] * v[j][3]); }
        const float rstd = rsqrtf(wave_sum(q) * (1.f / D) + LN_EPS);
#pragma unroll
        for (int j = 0; j < 8; ++j) { const f32x4 gg = ((const f32x4*)g)[lane + 64 * j], bb = ((const f32x4*)b)[lane + 64 * j];
            v[j] = v[j] * rstd * gg + bb;
            if (XF) ((f32x4*)(XF + (size_t)row * D))[lane + 64 * j] = v[j];
            if (XBo) { u32x2 w; w.x = cvt_pk_bf16(v[j][0], v[j][1]); w.y = cvt_pk_bf16(v[j][2], v[j][3]); ((u32x2*)(XBo + (size_t)row * D))[lane + 64 * j] = w; } }
        if (ROUTE) {
            float acc[NE];
#pragma unroll
            for (int e = 0; e < NE; ++e) acc[e] = 0.f;
#pragma unroll
            for (int j = 0; j < 8; ++j)
#pragma unroll
                for (int i = 0; i < 4; ++i) { const int d = 4 * (lane + 64 * j) + i; const float xv = v[j][i];
                    const f32x4 w0 = *(const f32x4*)(Wr + (size_t)d * NE), w1 = *(const f32x4*)(Wr + (size_t)d * NE + 4);
                    acc[0] = fmaf(xv, w0[0], acc[0]); acc[1] = fmaf(xv, w0[1], acc[1]); acc[2] = fmaf(xv, w0[2], acc[2]); acc[3] = fmaf(xv, w0[3], acc[3]);
                    acc[4] = fmaf(xv, w1[0], acc[4]); acc[5] = fmaf(xv, w1[1], acc[5]); acc[6] = fmaf(xv, w1[2], acc[6]); acc[7] = fmaf(xv, w1[3], acc[7]); }
#pragma unroll
            for (int e = 0; e < NE; ++e) acc[e] = wave_sum(acc[e]);
            if (lane == 0) {
                int i0 = 0; float l0 = acc[0];
#pragma unroll
                for (int e = 1; e < NE; ++e) if (acc[e] > l0) { l0 = acc[e]; i0 = e; }
                int i1 = -1; float l1 = -3.4e38f;
#pragma unroll
                for (int e = 0; e < NE; ++e) if (e != i0 && acc[e] > l1) { l1 = acc[e]; i1 = e; }
                const float e1 = expf(l1 - l0), w0 = 1.f / (1.f + e1), w1 = e1 / (1.f + e1);
                const int p0 = atomicAdd(&cnt[i0], 1), p1 = atomicAdd(&cnt[i1], 1);
                tinfo_o[row * 4 + 0] = i0; tinfo_o[row * 4 + 1] = p0; tinfo_o[row * 4 + 2] = i1; tinfo_o[row * 4 + 3] = p1;
                tw_o[row * 2] = w0; tw_o[row * 2 + 1] = w1;
            }
        }
    }
}
__device__ __forceinline__ void moe_table(Frame& F, const int* cnt) {
    if (F.tid == 0) { int acc = 0;
        for (int e = 0; e < NE; ++e) { F.MISC[16 + e] = (unsigned)acc; acc += (__hip_atomic_load(cnt + e, RLX_AGENT) + 255) / 256; }
        F.MISC[16 + NE] = (unsigned)acc; }
    __syncthreads();
}
__device__ __forceinline__ void gather_phase(Frame& F, const bf16* __restrict__ X1B, const int* __restrict__ tinfo, bf16* __restrict__ XG) {
    const int gw = F.vcu * NWAVES + F.wave, NGW = F.G * NWAVES, lane = F.lane;
    for (int it = gw; it < 2 * S; it += NGW) {
        const int t = it >> 1, k = it & 1;
        const int e = tinfo[t * 4 + 2 * k], pos = tinfo[t * 4 + 2 * k + 1];
        const int row = 256 * (int)F.MISC[16 + e] + pos;
        const u32x4* src = (const u32x4*)(X1B + (size_t)t * D); u32x4* dst = (u32x4*)(XG + (size_t)row * D);
#pragma unroll
        for (int j = 0; j < 4; ++j) dst[lane + 64 * j] = src[lane + 64 * j];
    }
}

constexpr int N_PHASES = 18;
__global__ void __launch_bounds__(NTHREADS, 2) mega(Params p) {
    extern __shared__ __attribute__((aligned(16))) unsigned char lds_raw[];
    Frame F;
    F.lds = (LAS unsigned char*)lds_raw;
    F.MISC = (volatile LAS unsigned*)(F.lds + MISC_OFF);
    F.tid = threadIdx.x; F.lane = F.tid & 63; F.wave = __builtin_amdgcn_readfirstlane(F.tid >> 6);
    F.G = gridDim.x; { const int bx = blockIdx.x; F.vcu = (F.G % 8 == 0) ? (bx % 8) * (F.G / 8) + bx / 8 : bx; }
    unsigned char* ws = p.ws;
    F.ctl = (gu32*)(ws + WS_CTL);
    for (int u = F.tid; u < (LDS_BYTES - LDSCTL_OFF) / 4; u += NTHREADS) ((LAS unsigned*)(F.lds + LDSCTL_OFF))[u] = 0u;
    __syncthreads();
    const int lo = p.ph_lo, hi = p.ph_hi;
    XcdBarrier bar; bar.bar = (unsigned*)(ws + WS_CTL) + CW_BAR + p.li * XCD_BAR_WORDS; bar.x = 0; bar.st = nullptr;
    if (hi - lo > 1) bar = xcd_barrier_post((unsigned*)(ws + WS_CTL) + CW_BAR + p.li * XCD_BAR_WORDS, F.MISC + 8);
#ifndef PH_ENABLE
#define PH_ENABLE 0x3FFFFu
#endif
#define IN(k) ((((unsigned)PH_ENABLE >> ((k) % 32)) & 1u) && lo <= (k) && (k) < hi)
#define SEAM(k) do { if (IN(k) && IN((k) + 1)) xcd_barrier(bar); } while (0)

    int* cnt = (int*)(ws + WS_CTL) + CW_CNT; int* tinfo = (int*)(ws + WS_TINFO); float* tw = (float*)(ws + WS_TW);
    bf16* XB = (bf16*)(ws + WS_XB); float* XC = (float*)(ws + WS_XC); float* X1 = (float*)(ws + WS_X1); bf16* X1B = (bf16*)(ws + WS_X1B);
    float* Y = (float*)(ws + WS_Y); bf16* XG = (bf16*)(ws + WS_XG); float* YS = (float*)(ws + WS_YS);
    bf16* P = (bf16*)(ws + WS_P); bf16* AO = (bf16*)(ws + WS_AO); bf16* SO = (bf16*)(ws + WS_SO); float* T = (float*)(ws + WS_T); bf16* MG = (bf16*)(ws + WS_MG);
    bf16* H = (bf16*)(ws + WS_H);
    const int bx = (int)blockIdx.x;

    if (IN(0)) { p0_convert(F, p); } SEAM(0);

#define COMMON_PHASES(layer) do { \
        const int pb = 1 + 8 * layer; \
        const float* xres = layer == 0 ? p.in[0] : XC; \
        if (IN(pb + 0)) { \
            pg8::SchedPlain Sc; Sc.init(XB, D, (const bf16*)(ws + WS_WIN) + (size_t)layer * DIN * D, D, S, DIN, F.G, bx); \
            pg8::EpiProj E{P, p.in[2] + layer * 2 * D}; \
            pg8::gemm_phase<pg8::EpiProj, pg8::SchedPlain>(F.lds, D, D, D, Sc, E); \
        } SEAM(pb + 0); \
        if (IN(pb + 1)) { \
            if (p.sub & 1) for (int u = F.vcu; u < NH * (S / 256); u += F.G) att::attn_unit(P, AO, u / (S / 256), u % (S / 256), F.lds, F.tid, F.wave, F.lane); \
            if (p.sub & 2) for (int u = F.vcu; u < (S / 128) * NG; u += F.G) \
                att::sgu_unit(P, SO, p.in[3] + (size_t)layer * NG * 128 * 128, p.in[4] + layer * NG * 128, p.in[5] + layer * SBW, p.in[6] + layer * SBW, u >> 3, u & 7, F.lds, F.tid, F.wave, F.lane); \
        } SEAM(pb + 1); \
        if (IN(pb + 2)) { \
            pg8::SchedTwoSeg Sc; Sc.init(AO, SO, SBW, (const bf16*)(ws + WS_WA) + (size_t)layer * D * SBW, (const bf16*)(ws + WS_WB) + (size_t)layer * D * SBW, SBW, S, D, F.G, bx); \
            pg8::EpiBranch E{T, MG, P}; \
            pg8::gemm_phase<pg8::EpiBranch, pg8::SchedTwoSeg>(F.lds, SBW, SBW, SBW, Sc, E); \
        } SEAM(pb + 2); \
        if (IN(pb + 3)) { \
            pg8::SchedPlain Sc; Sc.init(MG, D, (const bf16*)(ws + WS_WOUT) + (size_t)layer * D * D, D, S, D, F.G, bx); \
            pg8::EpiResid E{Y, xres}; \
            pg8::gemm_phase<pg8::EpiResid, pg8::SchedPlain>(F.lds, D, D, D, Sc, E); \
        } SEAM(pb + 3); \
    } while (0)
    COMMON_PHASES(0);

            if (IN(5)) { ln_phase<0, false>(F, Y, nullptr, nullptr, nullptr, nullptr, p.in[10], p.in[11], X1, X1B, nullptr, nullptr, nullptr, nullptr); } SEAM(5);
            if (IN(6)) {
                pg8::SchedPlain Sc; Sc.init(X1B, D, (const bf16*)(ws + WS_W13D), D, S, 2 * FF_D, F.G, bx);
                pg8::EpiSwiGlu E{H, FF_D};
                pg8::gemm_phase<pg8::EpiSwiGlu, pg8::SchedPlain>(F.lds, D, D, D, Sc, E);
            } SEAM(6);
            if (IN(7)) {
                pg8::SchedPlain Sc; Sc.init(H, FF_D, (const bf16*)(ws + WS_W2D), FF_D, S, D, F.G, bx);
                pg8::EpiResid E{Y, X1};
                pg8::gemm_phase<pg8::EpiResid, pg8::SchedPlain>(F.lds, FF_D, FF_D, FF_D, Sc, E);
            } SEAM(7);
            if (IN(8)) { ln_phase<0, false>(F, Y, nullptr, nullptr, nullptr, nullptr, p.in[19], p.in[20], XC, XB, nullptr, nullptr, nullptr, nullptr); } SEAM(8);
    COMMON_PHASES(1);

            if (IN(13)) { ln_phase<0, true>(F, Y, nullptr, nullptr, nullptr, nullptr, p.in[10] + D, p.in[11] + D, X1, X1B, p.in[15], cnt, tinfo, tw); } SEAM(13);
            if (IN(14)) { moe_table(F, cnt); gather_phase(F, X1B, tinfo, XG); } SEAM(14);
            if (IN(15)) {
                moe_table(F, cnt);
                pg8::SchedMoe Sc; Sc.init(XG, D, (const bf16*)(ws + WS_W13E), D, 2 * FF_E, (const volatile LAS int*)(F.MISC + 16), F.G, bx);
                pg8::EpiSwiGlu E{H, FF_E};
                pg8::gemm_phase<pg8::EpiSwiGlu, pg8::SchedMoe>(F.lds, D, D, D, Sc, E);
            } SEAM(15);
            if (IN(16)) {
                moe_table(F, cnt);
                pg8::SchedMoe Sc; Sc.init(H, FF_E, (const bf16*)(ws + WS_W2E), FF_E, D, (const volatile LAS int*)(F.MISC + 16), F.G, bx);
                pg8::EpiResid E{YS, nullptr};
                pg8::gemm_phase<pg8::EpiResid, pg8::SchedMoe>(F.lds, FF_E, FF_E, FF_E, Sc, E);
            } SEAM(16);
            if (IN(17)) { moe_table(F, cnt); ln_phase<1, false>(F, nullptr, X1, YS, tinfo, tw, p.in[19] + D, p.in[20] + D, p.out, nullptr, nullptr, nullptr, nullptr, nullptr); }
#undef COMMON_PHASES
#undef IN
#undef SEAM
}
}

#ifndef NEW_MASK
#define NEW_MASK 0x3FFFFu
#endif
#ifndef NEW_ATT
#define NEW_ATT 1
#endif
#ifndef NEW_SGU
#define NEW_SGU 1
#endif
#ifndef FUSE
#define FUSE 1
#endif
extern "C" void kernel_launch(void* const* d_in, const int* in_sizes, int n_in, void* d_out, int out_size, void* d_ws, size_t ws_size, hipStream_t stream) {
    static int grid = 0;
    if (grid == 0) {
        if (n_in != 21 || ws_size < WS_END) { fprintf(stderr, "kernel_launch: unexpected n_in %d / ws %zu (need %zu)\n", n_in, ws_size, (size_t)WS_END); grid = -1; return; }
        int dev = 0, cus = 0, per_cu = 0;
        if (hipGetDevice(&dev) != hipSuccess || hipDeviceGetAttribute(&cus, hipDeviceAttributeMultiprocessorCount, dev) != hipSuccess) { grid = -1; return; }
        if (hipFuncSetAttribute((const void*)mk::mega, hipFuncAttributeMaxDynamicSharedMemorySize, mk::LDS_BYTES) != hipSuccess) { fprintf(stderr, "kernel_launch: hipFuncSetAttribute failed\n"); grid = -1; return; }
        if (hipOccupancyMaxActiveBlocksPerMultiprocessor(&per_cu, (const void*)mk::mega, mk::NTHREADS, mk::LDS_BYTES) != hipSuccess || per_cu < 1) { fprintf(stderr, "kernel_launch: occupancy query says %d\n", per_cu); }
        (void)hipGetLastError();
        grid = cus;
    }
    if (grid < 0) return;
    char* ws = (char*)d_ws;
    (void)hipMemsetAsync(ws + WS_CTL, 0, CTL_ZERO_BYTES, stream);
    mk::Params prm{};
    for (int i = 0; i < 21; ++i) prm.in[i] = (const float*)d_in[i];
    prm.out = (float*)d_out; prm.ws = (unsigned char*)d_ws; prm.sub = (NEW_ATT ? 1 : 0) | (NEW_SGU ? 2 : 0);
    const unsigned mask = NEW_MASK;
#if NEW_MASK != 0x3FFFFu || !NEW_ATT || !NEW_SGU
    const float* x_in = (const float*)d_in[0];
    const float* w_in = (const float*)d_in[1];   const float* b_gate = (const float*)d_in[2];
    const float* sg_w = (const float*)d_in[3];   const float* sg_b = (const float*)d_in[4];
    const float* sg_ln_g = (const float*)d_in[5]; const float* sg_ln_b = (const float*)d_in[6];
    const float* w_a = (const float*)d_in[7];    const float* w_b = (const float*)d_in[8];   const float* w_out = (const float*)d_in[9];
    const float* ln1_g = (const float*)d_in[10]; const float* ln1_b = (const float*)d_in[11];
    const float* ffn_w1 = (const float*)d_in[12]; const float* ffn_w3 = (const float*)d_in[13]; const float* ffn_w2 = (const float*)d_in[14];
    const float* moe_router = (const float*)d_in[15];
    const float* moe_w1 = (const float*)d_in[16]; const float* moe_w3 = (const float*)d_in[17]; const float* moe_w2 = (const float*)d_in[18];
    const float* ln2_g = (const float*)d_in[19]; const float* ln2_b = (const float*)d_in[20];
    float* out = (float*)d_out;
    int* cnt = (int*)(ws + WS_CTL) + CW_CNT; int* tinfo = (int*)(ws + WS_TINFO); float* tw = (float*)(ws + WS_TW);
    bf16* XB = (bf16*)(ws + WS_XB); float* XC = (float*)(ws + WS_XC); float* X1 = (float*)(ws + WS_X1); bf16* X1B = (bf16*)(ws + WS_X1B);
    float* Y = (float*)(ws + WS_Y); bf16* XG = (bf16*)(ws + WS_XG); float* YS = (float*)(ws + WS_YS);
    bf16* P = (bf16*)(ws + WS_P); bf16* AO = (bf16*)(ws + WS_AO); bf16* SO = (bf16*)(ws + WS_SO); float* T = (float*)(ws + WS_T); bf16* MG = (bf16*)(ws + WS_MG);
    bf16* H = (bf16*)(ws + WS_H); float* LNV = T;
    const dim3 blk(256);
#endif
    int li = 0;
    for (int ph = 0; ph < mk::N_PHASES;) {
        if (mask & (1u << ph)) {
            int hi = ph + 1;
            if (FUSE) while (hi < mk::N_PHASES && (mask & (1u << hi)) && !(((hi - 1) == 2 || (hi - 1) == 10) && !(NEW_ATT && NEW_SGU))) ++hi;
            prm.ph_lo = ph; prm.ph_hi = hi; prm.li = li++;
            hipLaunchKernelGGL(mk::mega, dim3(grid), dim3(mk::NTHREADS), mk::LDS_BYTES, stream, prm);
#if NEW_MASK != 0x3FFFFu || !NEW_ATT || !NEW_SGU
            if (ph <= 2 && 2 < hi) { if (!NEW_ATT) hipLaunchKernelGGL(nv::attn, dim3(S * NH / 4), blk, 0, stream, P, AO);
                if (!NEW_SGU) { hipLaunchKernelGGL(nv::sgu_ln, dim3(S * NG / 4), blk, 0, stream, P, sg_ln_g, sg_ln_b, LNV); hipLaunchKernelGGL(nv::sgu_mix, dim3(64 * NG), blk, 0, stream, P, LNV, sg_w, sg_b, SO); } }
            if (ph <= 10 && 10 < hi) { if (!NEW_ATT) hipLaunchKernelGGL(nv::attn, dim3(S * NH / 4), blk, 0, stream, P, AO);
                if (!NEW_SGU) { hipLaunchKernelGGL(nv::sgu_ln, dim3(S * NG / 4), blk, 0, stream, P, sg_ln_g + SBW, sg_ln_b + SBW, LNV); hipLaunchKernelGGL(nv::sgu_mix, dim3(64 * NG), blk, 0, stream, P, LNV, sg_w + (size_t)NG * 128 * 128, sg_b + NG * 128, SO); } }
#endif
            ph = hi; continue;
        }
#if NEW_MASK != 0x3FFFFu || !NEW_ATT || !NEW_SGU
        const int layer = ph >= 9 ? 1 : 0; const int k = ph == 0 ? -1 : (ph - 1) % 8 + (ph >= 14 ? 8 : 0);
        const float* xres = layer == 0 ? x_in : XC;
        if (ph == 0) hipLaunchKernelGGL(nv::cvt_bf16, dim3(2048), blk, 0, stream, x_in, XB, (size_t)S * D / 4);
        else if (ph == 1 || ph == 9) hipLaunchKernelGGL((nv::gemm<bf16, nv::EpiProj, false>), dim3(DIN / 64, S / 64), blk, 0, stream, XB, nullptr, w_in + (size_t)layer * D * DIN, nullptr, D, 0, DIN, S, DIN, D, nv::EpiProj{P, b_gate + layer * 2 * D});
        else if (ph == 2 || ph == 10) { hipLaunchKernelGGL(nv::attn, dim3(S * NH / 4), blk, 0, stream, P, AO);
            hipLaunchKernelGGL(nv::sgu_ln, dim3(S * NG / 4), blk, 0, stream, P, sg_ln_g + layer * SBW, sg_ln_b + layer * SBW, LNV);
            hipLaunchKernelGGL(nv::sgu_mix, dim3(64 * NG), blk, 0, stream, P, LNV, sg_w + (size_t)layer * NG * 128 * 128, sg_b + layer * NG * 128, SO); }
        else if (ph == 3 || ph == 11) { hipLaunchKernelGGL((nv::gemm<bf16, nv::EpiGateA, false>), dim3(D / 64, S / 64), blk, 0, stream, AO, nullptr, w_a + (size_t)layer * SBW * D, nullptr, SBW, 0, D, S, D, SBW, nv::EpiGateA{T, P});
            hipLaunchKernelGGL((nv::gemm<bf16, nv::EpiGateB, false>), dim3(D / 64, S / 64), blk, 0, stream, SO, nullptr, w_b + (size_t)layer * SBW * D, nullptr, SBW, 0, D, S, D, SBW, nv::EpiGateB{T, P, MG}); }
        else if (ph == 4 || ph == 12) hipLaunchKernelGGL((nv::gemm<bf16, nv::EpiResid, false>), dim3(D / 64, S / 64), blk, 0, stream, MG, nullptr, w_out + (size_t)layer * D * D, nullptr, D, 0, D, S, D, D, nv::EpiResid{Y, xres});
        else if (ph == 5) hipLaunchKernelGGL(nv::ln_rows, dim3(S / 4), blk, 0, stream, Y, nullptr, nullptr, nullptr, nullptr, nullptr, ln1_g, ln1_b, X1, X1B);
        else if (ph == 6) hipLaunchKernelGGL((nv::gemm<bf16, nv::EpiSwiGlu, true>), dim3(FF_D / 64, S / 64), blk, 0, stream, X1B, nullptr, ffn_w1, ffn_w3, D, 0, FF_D, S, FF_D, D, nv::EpiSwiGlu{H, FF_D});
        else if (ph == 7) hipLaunchKernelGGL((nv::gemm<bf16, nv::EpiResid, false>), dim3(D / 64, S / 64), blk, 0, stream, H, nullptr, ffn_w2, nullptr, FF_D, 0, D, S, D, FF_D, nv::EpiResid{Y, X1});
        else if (ph == 8) hipLaunchKernelGGL(nv::ln_rows, dim3(S / 4), blk, 0, stream, Y, nullptr, nullptr, nullptr, nullptr, nullptr, ln2_g, ln2_b, XC, XB);
        else if (ph == 13) { hipLaunchKernelGGL(nv::ln_rows, dim3(S / 4), blk, 0, stream, Y, nullptr, nullptr, nullptr, nullptr, nullptr, ln1_g + D, ln1_b + D, X1, X1B);
            hipLaunchKernelGGL(nv::moe_route, dim3(S / 4), blk, 0, stream, X1, moe_router, cnt, tinfo, tw); }
        else if (ph == 14) hipLaunchKernelGGL(nv::moe_gather, dim3(S * 2 / 4), blk, 0, stream, X1B, tinfo, cnt, XG);
        else if (ph == 15) { for (int e = 0; e < NE; ++e) hipLaunchKernelGGL((nv::gemm<bf16, nv::EpiSwiGlu, true>), dim3(FF_E / 64, S / 64), blk, 0, stream, XG, cnt, moe_w1 + (size_t)e * D * FF_E, moe_w3 + (size_t)e * D * FF_E, D, e, FF_E, S, FF_E, D, nv::EpiSwiGlu{H, FF_E}); }
        else if (ph == 16) { for (int e = 0; e < NE; ++e) hipLaunchKernelGGL((nv::gemm<bf16, nv::EpiStoreF, false>), dim3(D / 64, S / 64), blk, 0, stream, H, cnt, moe_w2 + (size_t)e * FF_E * D, nullptr, FF_E, e, D, S, D, FF_E, nv::EpiStoreF{YS, D}); }
        else if (ph == 17) hipLaunchKernelGGL(nv::ln_rows, dim3(S / 4), blk, 0, stream, nullptr, X1, YS, tinfo, tw, cnt, ln2_g + D, ln2_b + D, out, nullptr);
        (void)k;
#endif
        ++ph;
    }
}
```

```cpp
#define NEW_MASK 0x3FFFF
#include <hip/hip_runtime.h>
#include <cstdio>
#include <cstdint>

typedef unsigned short bf16;
constexpr int S = 8192, D = 2048, DIN = 9216, SBW = 1024, NH = 8, HD = 128, NG = 8;
constexpr int OFF_Q = 0, OFF_K = 1024, OFF_V = 2048, OFF_U = 3072, OFF_VG = 4096, OFF_GATE = 5120;
constexpr int FF_D = 5504, FF_E = 7168, NE = 8;
constexpr int MAXSLOT = 2 * S + NE * 256;
constexpr float ALPHA = 1.4142135623730951f;
constexpr float LN_EPS = 1e-5f;
constexpr float QSCALE = 0.08838834764831845f * 1.4426950408889634f;

__host__ __device__ __forceinline__ unsigned f2bf_u(float f) { unsigned u = __builtin_bit_cast(unsigned, f); return (u + 0x7fffu + ((u >> 16) & 1u)) >> 16; }
__host__ __device__ __forceinline__ bf16 f2bf(float f) { return (bf16)f2bf_u(f); }
__host__ __device__ __forceinline__ float bf2f(bf16 b) { return __builtin_bit_cast(float, ((unsigned)b) << 16); }
__host__ __device__ __forceinline__ unsigned pk2(float lo, float hi) { return f2bf_u(lo) | (f2bf_u(hi) << 16); }

constexpr size_t MiB = 1u << 20;
constexpr size_t WS_CTL = 0, CTL_ZERO_BYTES = 1 * MiB;
constexpr size_t WS_TINFO = 1 * MiB;
constexpr size_t WS_TW = WS_TINFO + (size_t)S * 16;
constexpr size_t WS_WIN = 2 * MiB;
constexpr size_t WS_WA = WS_WIN + 72 * MiB;
constexpr size_t WS_WB = WS_WA + 8 * MiB;
constexpr size_t WS_WOUT = WS_WB + 8 * MiB;
constexpr size_t WS_W13D = WS_WOUT + 16 * MiB;
constexpr size_t WS_W2D = WS_W13D + 43 * MiB;
constexpr size_t WS_W13E = WS_W2D + 22 * MiB;
constexpr size_t WS_W2E = WS_W13E + 448 * MiB;
constexpr size_t WS_XB = WS_W2E + 224 * MiB;
constexpr size_t WS_XC = WS_XB + 32 * MiB;
constexpr size_t WS_X1 = WS_XC + 64 * MiB;
constexpr size_t WS_X1B = WS_X1 + 64 * MiB;
constexpr size_t WS_Y = WS_X1B + 32 * MiB;
constexpr size_t WS_YS2 = WS_Y;
constexpr size_t WS_YS = WS_Y + 72 * MiB;
constexpr size_t WS_A = WS_YS + 144 * MiB;
constexpr size_t WS_P = WS_A;
constexpr size_t WS_AO = WS_P + 144 * MiB;
constexpr size_t WS_SO = WS_AO + 16 * MiB;
constexpr size_t WS_T = WS_SO + 16 * MiB;
constexpr size_t WS_MG = WS_T + 64 * MiB;
constexpr size_t WS_H = WS_A;
constexpr size_t WS_END = WS_A + 272 * MiB;
constexpr size_t WS_XG = WS_END;
constexpr size_t WS_END2 = WS_XG + 256 * MiB;
static_assert(WS_MG + 32 * MiB == WS_END && WS_END2 <= 1792 * MiB, "d_ws map");
constexpr int CW_TMO = 0, CW_CODE = 1;
constexpr int CW_CNT = 64;
constexpr int CW_BAR = 4096;
namespace mk {
#define LAS __attribute__((address_space(3)))
#define GAS __attribute__((address_space(1)))
typedef short bf16x8 __attribute__((ext_vector_type(8)));
typedef short s16x4 __attribute__((ext_vector_type(4)));
typedef float f32x2 __attribute__((ext_vector_type(2)));
typedef float f32x4 __attribute__((ext_vector_type(4)));
typedef float f32x16 __attribute__((ext_vector_type(16)));
typedef unsigned u32x2 __attribute__((ext_vector_type(2)));
typedef unsigned u32x4 __attribute__((ext_vector_type(4)));
typedef GAS unsigned gu32;

constexpr int NWAVES = 8, NTHREADS = 512;
struct Params { const float* in[21]; float* out; unsigned char* ws; int ph_lo, ph_hi, li, sub; };
static_assert(sizeof(Params) == 21 * 8 + 8 + 8 + 16, "Params has no holes");
constexpr int RING_BYTES = 131072;
constexpr int LDSCTL_OFF = RING_BYTES, MISC_OFF = LDSCTL_OFF + 320;
constexpr int LDS_BYTES = 147456;
#define RLX_AGENT __ATOMIC_RELAXED, __HIP_MEMORY_SCOPE_AGENT
#define LDS_WAIT() asm volatile("s_waitcnt lgkmcnt(0)" ::: "memory")
#define VM_WAIT() asm volatile("s_waitcnt vmcnt(0)" ::: "memory")
#define SBAR() __builtin_amdgcn_sched_barrier(0)

__device__ __forceinline__ unsigned cvt_pk_bf16(float lo, float hi) { unsigned r; asm volatile("v_cvt_pk_bf16_f32 %0, %1, %2" : "=v"(r) : "v"(lo), "v"(hi)); return r; }
__device__ __forceinline__ float fast_exp2(float x) { return __builtin_amdgcn_exp2f(x); }
__device__ __forceinline__ float fast_log2(float x) { return __builtin_amdgcn_logf(x); }
__device__ __forceinline__ float fast_rcp(float x) { return __builtin_amdgcn_rcpf(x); }
__device__ __forceinline__ float sigmoid_f(float x) { return fast_rcp(1.f + fast_exp2(-1.4426950408889634f * x)); }
__device__ __forceinline__ float gelu_tanh_f(float x) { const float y2 = 2.f * 0.7978845608028654f * 1.4426950408889634f * (x + 0.044715f * x * x * x); return x * fast_rcp(1.f + fast_exp2(-y2)); }

#define XB_TMO      128
#define XB_XCNT(j)  (256  + 64 * (j))
#define XB_XSUB(j)  (1280 + 64 * (j))
#define XB_XGEN(j)  (2304 + 64 * (j))
#define XB_TOP      3328
#define XB_TOPGEN   3392
#define XCD_BAR_WORDS 3456
#define XB_SPIN_CAP (1u << 22)
__device__ __forceinline__ unsigned xb_ld(unsigned* p)              { return __hip_atomic_load(p, __ATOMIC_RELAXED, __HIP_MEMORY_SCOPE_AGENT); }
__device__ __forceinline__ unsigned xb_add(unsigned* p, unsigned v) { return __hip_atomic_fetch_add(p, v, __ATOMIC_RELAXED, __HIP_MEMORY_SCOPE_AGENT); }
__device__ __forceinline__ unsigned xb_xcc_id() { return (unsigned)__builtin_amdgcn_s_getreg((3 << 11) | 20) & 0xFu; }
#define XB_SPIN(cond, bar) do { unsigned _sp = 0; while (cond) { __builtin_amdgcn_s_sleep(1); \
    if ((++_sp & 255u) == 0u) { if (xb_ld(&(bar)[XB_TMO])) break; if (_sp > XB_SPIN_CAP) { atomicAdd(&(bar)[XB_TMO], 1u); break; } } } } while (0)
struct XcdBarrier { unsigned* bar; unsigned x; volatile LAS unsigned* st; };
__device__ __forceinline__ XcdBarrier xcd_barrier_post(unsigned* bar, volatile LAS unsigned* st) {
    XcdBarrier b; b.bar = bar; b.x = xb_xcc_id(); b.st = st;
    if (threadIdx.x == 0) (void)xb_add(&bar[XB_XCNT(b.x)], 1u);
    return b;
}
__device__ __forceinline__ void xcd_barrier_complete(unsigned* bar, unsigned x, unsigned& nloc, unsigned& nx) {
    const unsigned G = gridDim.x * gridDim.y * gridDim.z;
    unsigned sum, cnt, mine, sp = 0u;
    for (;;) {
        sum = 0u; cnt = 0u; mine = 0u;
#pragma unroll
        for (unsigned j = 0; j < 16; ++j) { const unsigned c = xb_ld(&bar[XB_XCNT(j)]); sum += c; cnt += (c > 0u) ? 1u : 0u; mine = (j == x) ? c : mine; }
        if (sum == G) break;
        __builtin_amdgcn_s_sleep(1);
        if ((++sp & 255u) == 0u) { if (xb_ld(&bar[XB_TMO])) break; if (sp > XB_SPIN_CAP) { atomicAdd(&bar[XB_TMO], 1u); break; } }
    }
    nloc = mine > 0u ? mine : 1u; nx = cnt > 0u ? cnt : 1u;
}
__device__ __forceinline__ void xcd_barrier(const XcdBarrier& b) {
    asm volatile("s_waitcnt vmcnt(0)" ::: "memory");
    __syncthreads();
    if (threadIdx.x == 0) {
        unsigned* bar = b.bar;
        __builtin_amdgcn_s_waitcnt(0);
        unsigned nloc = b.st[0], nx = b.st[1];
        if (nloc == 0u) { xcd_barrier_complete(bar, b.x, nloc, nx); b.st[0] = nloc; b.st[1] = nx; }
        const unsigned old = xb_add(&bar[XB_XSUB(b.x)], 1u);
        const unsigned gen = old / nloc;
        if (old + 1u == (gen + 1u) * nloc) {
            __builtin_amdgcn_fence(__ATOMIC_RELEASE, "agent");
            asm volatile("s_waitcnt vmcnt(0)" ::: "memory");
            const unsigned og = xb_add(&bar[XB_TOP], 1u);
            const unsigned tg = og / nx;
            if (og + 1u == (tg + 1u) * nx) xb_add(&bar[XB_TOPGEN], 1u);
            else XB_SPIN(xb_ld(&bar[XB_TOPGEN]) == tg, bar);
            __builtin_amdgcn_fence(__ATOMIC_ACQUIRE, "agent");
            xb_add(&bar[XB_XGEN(b.x)], 1u);
            asm volatile("s_waitcnt vmcnt(0)" ::: "memory");
        } else {
            XB_SPIN(xb_ld(&bar[XB_XGEN(b.x)]) == gen, bar);
            __builtin_amdgcn_fence(__ATOMIC_ACQUIRE, "agent");
            asm volatile("s_waitcnt vmcnt(0)" ::: "memory");
        }
    }
    __syncthreads();
}

namespace pg8 {
constexpr int BM = 256, BK = 64, HALF = 128, HTB = HALF * BK * 2, STAGE_BYTES = 8 * HTB, NXCD = 8, WGM = 8;
__host__ __device__ __forceinline__ int lds_byte(int r, int c) { const int st = (r >> 4) * 2 + (c >> 5), rr = r & 15, cc = c & 31, ob = rr * 64 + cc * 2; return st * 1024 + (ob ^ (((ob >> 9) & 1) << 5)); }
__host__ __device__ __forceinline__ void stage_rc(int b, int& R, int& C) { const int st = b / 1024, sb = b % 1024, swz = sb ^ (((sb >> 9) & 1) << 5); R = (st >> 1) * 16 + swz / 64; C = (st & 1) * 32 + (swz % 64) / 2; }
__host__ __device__ __forceinline__ int perm32(int rho) { const int n = rho >> 4, i = rho & 15; return 8 * (i >> 2) + 4 * n + (i & 3); }

struct Unit { int pm, pn, kind, aux, nt, pad; const char* a; const char* b0; const char* b1; };
struct TileOrder {
    int nM, nN, nwg, G, c;
    __device__ __forceinline__ void init(int nM_, int nN_, int G_, int c_) { nM = nM_; nN = nN_; nwg = nM * nN; G = G_; c = c_; }
    __device__ __forceinline__ bool map(int i, int& pm, int& pn) const {
        const long L = (long)i * G + c; if (L >= nwg) return false;
        int wgid = (int)L; { const int q = nwg / NXCD, r = nwg % NXCD, xcd = wgid % NXCD, off = wgid / NXCD; wgid = (xcd < r ? xcd * (q + 1) : r * (q + 1) + (xcd - r) * q) + off; }
        const int nig = WGM * nN, gid = wgid / nig, fm = gid * WGM, gsz = (nM - fm) < WGM ? (nM - fm) : WGM;
        pm = fm + ((wgid % nig) % gsz); pn = (wgid % nig) / gsz; return true;
    }
};

template <class Epi, class Sched>
__device__ __forceinline__ void gemm_phase(LAS unsigned char* lds, const int lda, const int ldb, const Sched& S, const Epi& E) {
    const int tid = threadIdx.x, wid = __builtin_amdgcn_readfirstlane(tid >> 6), lane = tid & 63, wr = wid >> 2, wc = wid & 3, fr = lane & 15, fq = lane >> 4;
    unsigned voffA[2], voffB[2];
#pragma unroll
    for (int i = 0; i < 2; ++i) { int R, C; stage_rc(tid * 16 + i * 8192, R, C); const int Rb = Epi::PERM ? ((R & ~31) + perm32(R & 31)) : R;
        voffA[i] = (unsigned)(R * lda + C) * 2u; voffB[i] = (unsigned)(Rb * ldb + C) * 2u; }
    const size_t kstep = (size_t)(BK * 2);
    const size_t hstepA = (size_t)HALF * lda * 2;
    const unsigned ldsw = (unsigned)wid * 1024u;
    const int aoff = lds_byte(wr * 64 + fr, fq * 8), boff = lds_byte(wc * 32 + fr, fq * 8);
#define PG8_SA(b, h) (((b) * 2 + (h)) * HTB)
#define PG8_SB(b, h) ((4 + (b) * 2 + (h)) * HTB)
#define PG8_STAGE(bufoff, gbase, voff) do { _Pragma("unroll") for (int _i = 0; _i < 2; ++_i) \
        __builtin_amdgcn_global_load_lds((const unsigned*)((const char*)(gbase) + (voff)[_i]), (LAS unsigned*)(lds + (bufoff) + ldsw + _i * 8192), 16, 0, 0); } while (0)
#define PG8_LDA(dst, b, h) do { _Pragma("unroll") for (int m = 0; m < 4; ++m) _Pragma("unroll") for (int k = 0; k < 2; ++k) dst[m][k] = *(const LAS bf16x8*)(lds + PG8_SA(b, h) + aoff + m * 2048 + k * 1024); } while (0)
#define PG8_LDB(dst, b, h) do { _Pragma("unroll") for (int n = 0; n < 2; ++n) _Pragma("unroll") for (int k = 0; k < 2; ++k) dst[n][k] = *(const LAS bf16x8*)(lds + PG8_SB(b, h) + boff + n * 2048 + k * 1024); } while (0)
#define PG8_MMA(ai, bj, At, Bt) do { __builtin_amdgcn_s_setprio(1); _Pragma("unroll") for (int m = 0; m < 4; ++m) _Pragma("unroll") for (int n = 0; n < 2; ++n) _Pragma("unroll") for (int k = 0; k < 2; ++k) \
        acc[ai][bj][m][n] = __builtin_amdgcn_mfma_f32_16x16x32_bf16(Bt[n][k], At[m][k], acc[ai][bj][m][n], 0, 0, 0); __builtin_amdgcn_s_setprio(0); } while (0)
#define PG8_WAIT_V(n) asm volatile("s_waitcnt vmcnt(" #n ")" ::: "memory")
#define PG8_WAIT_L(n) asm volatile("s_waitcnt lgkmcnt(" #n ")" ::: "memory")
#define PG8_BAR __builtin_amdgcn_s_barrier()
#define PG8_SCHED __builtin_amdgcn_sched_barrier(0)
    Unit cur, nxt; int ui = 0;
    if (!S.next(0, cur)) return;
    f32x4 acc[2][2][4][2];
#pragma unroll
    for (int a = 0; a < 2; ++a)
#pragma unroll
        for (int b = 0; b < 2; ++b)
#pragma unroll
            for (int m = 0; m < 4; ++m)
#pragma unroll
                for (int n = 0; n < 2; ++n) acc[a][b][m][n] = (f32x4){0.f, 0.f, 0.f, 0.f};
    bf16x8 At[4][2], B0[2][2], B1[2][2];
    PG8_STAGE(PG8_SB(0, 0), cur.b0, voffB); PG8_STAGE(PG8_SB(0, 1), cur.b1, voffB); PG8_STAGE(PG8_SA(0, 0), cur.a, voffA); PG8_STAGE(PG8_SA(0, 1), cur.a + hstepA, voffA);
    if (wr == 1) PG8_BAR;
    PG8_WAIT_V(2); PG8_BAR;
    PG8_STAGE(PG8_SB(1, 0), cur.b0 + kstep, voffB); PG8_STAGE(PG8_SA(1, 0), cur.a + kstep, voffA); PG8_STAGE(PG8_SB(1, 1), cur.b1 + kstep, voffB);
    PG8_WAIT_V(6); PG8_BAR;
    for (;;) {
        const bool has_next = S.next(ui + 1, nxt);
        const char* nA = has_next ? nxt.a : cur.a; const char* nB0 = has_next ? nxt.b0 : cur.b0; const char* nB1 = has_next ? nxt.b1 : cur.b1;
        const int nt = cur.nt;
        for (int t = 0; t < nt; t += 2) {
            const bool last = (t == nt - 2);
            const char* a1 = cur.a + (size_t)(t + 1) * kstep;
            const char* a2 = last ? nA : cur.a + (size_t)(t + 2) * kstep;
            const char* b2_0 = last ? nB0 : cur.b0 + (size_t)(t + 2) * kstep; const char* b2_1 = last ? nB1 : cur.b1 + (size_t)(t + 2) * kstep;
            const char* a3 = a2 + kstep; const char* b3_0 = b2_0 + kstep; const char* b3_1 = b2_1 + kstep;
            PG8_LDB(B0, 0, 0); PG8_LDB(B1, 0, 1); PG8_SCHED; PG8_LDA(At, 0, 0); PG8_STAGE(PG8_SA(1, 1), a1 + hstepA, voffA);
            PG8_WAIT_V(8); PG8_WAIT_L(0); PG8_BAR; PG8_MMA(0, 0, At, B0); PG8_MMA(0, 1, At, B1); PG8_BAR; PG8_SCHED;
            PG8_LDA(At, 0, 1); PG8_STAGE(PG8_SB(0, 0), b2_0, voffB); PG8_STAGE(PG8_SB(0, 1), b2_1, voffB); PG8_STAGE(PG8_SA(0, 0), a2, voffA);
            PG8_WAIT_V(8); PG8_WAIT_L(0); PG8_BAR; PG8_MMA(1, 0, At, B0); PG8_MMA(1, 1, At, B1); PG8_BAR; PG8_SCHED;
            PG8_LDB(B0, 1, 0); PG8_LDB(B1, 1, 1); PG8_SCHED; PG8_LDA(At, 1, 0); PG8_STAGE(PG8_SA(0, 1), a2 + hstepA, voffA);
            PG8_WAIT_V(8); PG8_WAIT_L(0); PG8_BAR; PG8_MMA(0, 0, At, B0); PG8_MMA(0, 1, At, B1); PG8_BAR; PG8_SCHED;
            PG8_LDA(At, 1, 1); PG8_STAGE(PG8_SB(1, 0), b3_0, voffB); PG8_STAGE(PG8_SB(1, 1), b3_1, voffB); PG8_STAGE(PG8_SA(1, 0), a3, voffA);
            PG8_WAIT_V(8); PG8_WAIT_L(0); PG8_BAR; PG8_MMA(1, 0, At, B0); PG8_MMA(1, 1, At, B1); PG8_BAR; PG8_SCHED;
        }
        if (wr == 0) PG8_BAR;
        E(acc, cur, wr, wc, fr, fq);
        if (!has_next) break;
#pragma unroll
        for (int a = 0; a < 2; ++a)
#pragma unroll
            for (int b = 0; b < 2; ++b)
#pragma unroll
                for (int m = 0; m < 4; ++m)
#pragma unroll
                    for (int n = 0; n < 2; ++n) acc[a][b][m][n] = (f32x4){0.f, 0.f, 0.f, 0.f};
        cur = nxt; ++ui;
        if (wr == 1) PG8_BAR;
    }
    PG8_WAIT_V(0);
    PG8_BAR;
#undef PG8_SA
#undef PG8_SB
#undef PG8_STAGE
#undef PG8_LDA
#undef PG8_LDB
#undef PG8_MMA
#undef PG8_WAIT_V
#undef PG8_WAIT_L
#undef PG8_BAR
#undef PG8_SCHED
}
}

namespace pg8 {
struct SchedPlain {
    TileOrder T; const char* A; const char* Bt; size_t tstepA, tstepB, hstepB; int nt;
    __device__ __forceinline__ void init(const bf16* A_, int lda, const bf16* Bt_, int ldb, int M, int N, int K, int G, int c) {
        nt = K / BK; T.init(M / BM, N / BM, G, c); A = (const char*)A_; Bt = (const char*)Bt_; tstepA = (size_t)BM * lda * 2; tstepB = (size_t)BM * ldb * 2; hstepB = (size_t)HALF * ldb * 2; }
    __device__ __forceinline__ bool next(int i, Unit& u) const {
        int pm, pn; if (!T.map(i, pm, pn)) return false;
        u.pm = pm; u.pn = pn; u.kind = 0; u.aux = 0; u.nt = nt; u.pad = 0; u.a = A + (size_t)pm * tstepA; u.b0 = Bt + (size_t)pn * tstepB; u.b1 = u.b0 + hstepB; return true; }
};
struct SchedTwoSeg {
    TileOrder T; const char* A0; const char* A1; const char* B0t; const char* B1t; size_t tstepA, tstepB, hstepB; int nt;
    __device__ __forceinline__ void init(const bf16* A0_, const bf16* A1_, int lda, const bf16* B0_, const bf16* B1_, int ldb, int M, int N, int K, int G, int c) {
        nt = K / BK; T.init(M / BM, N / BM, G, c); A0 = (const char*)A0_; A1 = (const char*)A1_; B0t = (const char*)B0_; B1t = (const char*)B1_; tstepA = (size_t)BM * lda * 2; tstepB = (size_t)BM * ldb * 2; hstepB = (size_t)HALF * ldb * 2; }
    __device__ __forceinline__ bool next(int i, Unit& u) const {
        int pm, pn; if (!T.map(i >> 1, pm, pn)) return false;
        const int seg = i & 1; u.pm = pm; u.pn = pn; u.kind = seg; u.aux = 0; u.nt = nt; u.pad = 0;
        u.a = (seg ? A1 : A0) + (size_t)pm * tstepA; u.b0 = (seg ? B1t : B0t) + (size_t)pn * tstepB; u.b1 = u.b0 + hstepB; return true; }
};
struct SchedMoeUp {
    TileOrder T; const char* A; const char* Bt; size_t tstepA, tstepB, hstepB, estepA, estepB; const volatile LAS int* pp; int nt;
    __device__ __forceinline__ void init(const bf16* A_, int lda, const bf16* Bt_, int ldb, int N, int K, const volatile LAS int* pp_, int G, int c) {
        pp = pp_; nt = K / BK; T.init(pp[NE], N / BM, G, c); A = (const char*)A_; Bt = (const char*)Bt_;
        tstepA = (size_t)BM * lda * 2; tstepB = (size_t)BM * ldb * 2; hstepB = (size_t)HALF * ldb * 2; estepA = (size_t)S * lda * 2; estepB = (size_t)N * ldb * 2; }
    __device__ __forceinline__ bool next(int i, Unit& u) const {
        int pm, pn; if (!T.map(i, pm, pn)) return false;
        int e = 0;
#pragma unroll
        for (int j = 1; j < NE; ++j) e += (pm >= pp[j]) ? 1 : 0;
        u.pm = pm; u.pn = pn; u.kind = 0; u.aux = e; u.nt = nt; u.pad = 0;
        u.a = A + (size_t)e * estepA + (size_t)(pm - pp[e]) * tstepA; u.b0 = Bt + (size_t)e * estepB + (size_t)pn * tstepB; u.b1 = u.b0 + hstepB; return true; }
};
constexpr int KSPLIT = 4;
struct SchedMoeDown {
    TileOrder T, T2; const char* A; const char* Bt; size_t tstepA, tstepB, hstepB, estepB, kslice; const volatile LAS int* pp; int nt, NF, nfu, G, c;
    __device__ __forceinline__ void init(const bf16* A_, int lda, const bf16* Bt_, int ldb, int N, int K, const volatile LAS int* pp_, int G_, int c_) {
        pp = pp_; nt = K / BK; G = G_; c = c_; const int np = pp[NE], nN = N / BM;
        NF = ((np * nN) / G) * G / nN; if (NF > np) NF = np; nfu = NF * nN;
        T.init(NF, nN, G, c); T2.init(np - NF, nN * KSPLIT, G, c); A = (const char*)A_; Bt = (const char*)Bt_;
        tstepA = (size_t)BM * lda * 2; tstepB = (size_t)BM * ldb * 2; hstepB = (size_t)HALF * ldb * 2; estepB = (size_t)N * ldb * 2; kslice = (size_t)(K / KSPLIT) * 2; }
    __device__ __forceinline__ bool next(int i, Unit& u) const {
        int pm, pn, q = 0, n = nt;
        const int r1 = (nfu + G - 1) / G;
        if (i < r1) { if (!T.map(i, pm, pn)) return false; }
        else { int pn4; if (!T2.map(i - r1, pm, pn4)) return false; pm += NF; pn = pn4 / KSPLIT; q = pn4 % KSPLIT; n = nt / KSPLIT; }
        int e = 0;
#pragma unroll
        for (int j = 1; j < NE; ++j) e += (pm >= pp[j]) ? 1 : 0;
        u.pm = pm; u.pn = pn; u.kind = (i < r1) ? 0 : 1 + q; u.aux = e; u.nt = n; u.pad = 0;
        u.a = A + (size_t)pm * tstepA + (size_t)q * kslice; u.b0 = Bt + (size_t)e * estepB + (size_t)pn * tstepB + (size_t)q * kslice; u.b1 = u.b0 + hstepB; return true; }
};

typedef const f32x4 (&AccRef)[2][2][4][2];
struct EpiProj {
    static constexpr bool PERM = true;
    bf16* P; const float* bgate;
    __device__ __forceinline__ void operator()(AccRef acc, const Unit& u, int wr, int wc, int fr, int fq) const {
        const int row0 = u.pm * BM + wr * 64 + fr, col0 = u.pn * BM + wc * 32 + 8 * fq;
        const int mode = u.pn < 4 ? 0 : (u.pn < 12 ? 1 : (u.pn < 20 ? 2 : 3));
        f32x4 bv[2][2];
#pragma unroll
        for (int bj = 0; bj < 2; ++bj)
#pragma unroll
            for (int n = 0; n < 2; ++n) bv[bj][n] = (mode == 3) ? *(const f32x4*)(bgate + (col0 - OFF_GATE) + bj * HALF + 4 * n) : (f32x4){0.f, 0.f, 0.f, 0.f};
#pragma unroll
        for (int ai = 0; ai < 2; ++ai)
#pragma unroll
            for (int m = 0; m < 4; ++m) { bf16* rowp = P + (size_t)(row0 + ai * HALF + m * 16) * DIN + col0;
#pragma unroll
                for (int bj = 0; bj < 2; ++bj) { f32x4 v0 = acc[ai][bj][m][0], v1 = acc[ai][bj][m][1];
                    if (mode == 0) { v0 = v0 * QSCALE; v1 = v1 * QSCALE; }
                    else if (mode == 2) {
#pragma unroll
                        for (int j = 0; j < 4; ++j) { v0[j] = gelu_tanh_f(v0[j]); v1[j] = gelu_tanh_f(v1[j]); } }
                    else if (mode == 3) { v0 = v0 + bv[bj][0]; v1 = v1 + bv[bj][1];
#pragma unroll
                        for (int j = 0; j < 4; ++j) { v0[j] = sigmoid_f(v0[j]); v1[j] = sigmoid_f(v1[j]); } }
                    u32x4 w; w.x = cvt_pk_bf16(v0[0], v0[1]); w.y = cvt_pk_bf16(v0[2], v0[3]); w.z = cvt_pk_bf16(v1[0], v1[1]); w.w = cvt_pk_bf16(v1[2], v1[3]);
                    *(u32x4*)(rowp + bj * HALF) = w; } }
    }
};
__device__ __forceinline__ f32x4 bf4_to_f32(u32x2 w) { f32x4 r; r[0] = __builtin_bit_cast(float, w.x << 16); r[1] = __builtin_bit_cast(float, w.x & 0xffff0000u); r[2] = __builtin_bit_cast(float, w.y << 16); r[3] = __builtin_bit_cast(float, w.y & 0xffff0000u); return r; }
struct EpiBranch {
    static constexpr bool PERM = false;
    float* T; bf16* MG; const bf16* P;
    __device__ __forceinline__ void operator()(AccRef acc, const Unit& u, int wr, int wc, int fr, int fq) const {
        const int row0 = u.pm * BM + wr * 64 + fr, col0 = u.pn * BM + wc * 32 + 4 * fq;
        const int goff = OFF_GATE + (u.kind ? D : 0);
#pragma unroll
        for (int ai = 0; ai < 2; ++ai)
#pragma unroll
            for (int m = 0; m < 4; ++m) { const size_t row = (size_t)(row0 + ai * HALF + m * 16);
#pragma unroll
                for (int bj = 0; bj < 2; ++bj)
#pragma unroll
                    for (int n = 0; n < 2; ++n) { const int col = col0 + bj * HALF + n * 16;
                        const f32x4 g = bf4_to_f32(*(const u32x2*)(P + row * DIN + goff + col));
                        if (u.kind == 0) { *(f32x4*)(T + row * D + col) = g * acc[ai][bj][m][n]; }
                        else { const f32x4 t = *(const f32x4*)(T + row * D + col); const f32x4 o = t + g * acc[ai][bj][m][n];
                            u32x2 w; w.x = cvt_pk_bf16(o[0], o[1]); w.y = cvt_pk_bf16(o[2], o[3]); *(u32x2*)(MG + row * D + col) = w; } } }
    }
};
struct EpiResid {
    static constexpr bool PERM = false;
    float* Y; const float* X;
    __device__ __forceinline__ void operator()(AccRef acc, const Unit& u, int wr, int wc, int fr, int fq) const {
        const int row0 = u.pm * BM + wr * 64 + fr, col0 = u.pn * BM + wc * 32 + 4 * fq;
#pragma unroll
        for (int ai = 0; ai < 2; ++ai)
#pragma unroll
            for (int m = 0; m < 4; ++m) { const size_t off = (size_t)(row0 + ai * HALF + m * 16) * D + col0;
#pragma unroll
                for (int bj = 0; bj < 2; ++bj)
#pragma unroll
                    for (int n = 0; n < 2; ++n) { f32x4 o = acc[ai][bj][m][n];
                        if (X) { const f32x4 x = *(const f32x4*)(X + off + bj * HALF + n * 16); o = o + x * ALPHA; }
                        *(f32x4*)(Y + off + bj * HALF + n * 16) = o; } }
    }
};
struct EpiMoeDown {
    static constexpr bool PERM = false;
    float* YS; float* YS2; int NF, pad;
    __device__ __forceinline__ void operator()(AccRef acc, const Unit& u, int wr, int wc, int fr, int fq) const {
        const int col0 = u.pn * BM + wc * 32 + 4 * fq;
        float* base; int row0;
        if (u.kind <= 1) { base = YS; row0 = u.pm * BM + wr * 64 + fr; }
        else { base = YS2 + (size_t)(u.kind - 2) * (8 * BM) * D; row0 = (u.pm - NF) * BM + wr * 64 + fr; }
#pragma unroll
        for (int ai = 0; ai < 2; ++ai)
#pragma unroll
            for (int m = 0; m < 4; ++m) { const size_t off = (size_t)(row0 + ai * HALF + m * 16) * D + col0;
#pragma unroll
                for (int bj = 0; bj < 2; ++bj)
#pragma unroll
                    for (int n = 0; n < 2; ++n) *(f32x4*)(base + off + bj * HALF + n * 16) = acc[ai][bj][m][n]; }
    }
};
struct EpiSwiGlu {
    static constexpr bool PERM = true;
    bf16* H; long ldh;
    __device__ __forceinline__ void operator()(AccRef acc, const Unit& u, int wr, int wc, int fr, int fq) const {
        const int row0 = u.pm * BM + wr * 64 + fr, col0 = u.pn * HALF + wc * 32 + 8 * fq;
#pragma unroll
        for (int ai = 0; ai < 2; ++ai)
#pragma unroll
            for (int m = 0; m < 4; ++m) { bf16* rowp = H + (size_t)(row0 + ai * HALF + m * 16) * ldh + col0;
                f32x4 o[2];
#pragma unroll
                for (int n = 0; n < 2; ++n) { const f32x4 a = acc[ai][0][m][n], b = acc[ai][1][m][n];
#pragma unroll
                    for (int j = 0; j < 4; ++j) o[n][j] = a[j] * sigmoid_f(a[j]) * b[j]; }
                u32x4 w; w.x = cvt_pk_bf16(o[0][0], o[0][1]); w.y = cvt_pk_bf16(o[0][2], o[0][3]); w.z = cvt_pk_bf16(o[1][0], o[1][1]); w.w = cvt_pk_bf16(o[1][2], o[1][3]);
                *(u32x4*)rowp = w; }
    }
};
}

struct Frame {
    LAS unsigned char* lds;
    volatile LAS unsigned* MISC;
    gu32* ctl;
    int tid, lane, wave, vcu, G;
};
__device__ __forceinline__ float wave_sum(float v) {
#pragma unroll
    for (int o = 1; o < 64; o <<= 1) v += __shfl_xor(v, o);
    return v;
}
__device__ __forceinline__ void cvt_tile(const float* __restrict__ W, int ldw, bf16* __restrict__ WT, int ldt, int k0, int n0, int rs, int ro, LAS unsigned char* scr, int lane) {
    const int kq = lane & 3, nq = lane >> 2;
    const float* src = W + (size_t)(k0 + kq) * ldw + n0 + 4 * nq;
    f32x4 v[16];
#pragma unroll
    for (int j = 0; j < 16; ++j) v[j] = *(const f32x4*)(src + (size_t)(4 * j) * ldw);
#pragma unroll
    for (int j = 0; j < 16; ++j) {
        const int k = 4 * j + kq;
        const unsigned w01 = cvt_pk_bf16(v[j][0], v[j][1]), w23 = cvt_pk_bf16(v[j][2], v[j][3]);
        const int cb = (((k >> 3) ^ (nq & 7)) << 4) | ((k & 7) << 1);
        LAS unsigned char* p = scr + (4 * nq) * 128 + cb;
        *(LAS unsigned short*)(p) = (unsigned short)(w01 & 0xffffu);
        *(LAS unsigned short*)(p + 128) = (unsigned short)(w01 >> 16);
        *(LAS unsigned short*)(p + 256) = (unsigned short)(w23 & 0xffffu);
        *(LAS unsigned short*)(p + 384) = (unsigned short)(w23 >> 16);
    }
    LDS_WAIT(); asm volatile("" ::: "memory");
    const int c = lane & 7;
#pragma unroll
    for (int r = 0; r < 8; ++r) {
        const int n = (lane >> 3) + 8 * r;
        const u32x4 o = *(const LAS u32x4*)(scr + n * 128 + ((c ^ ((n >> 2) & 7)) << 4));
        const int ng = n0 + n, drow = (ng >> 7) * rs + (ng & 127) + ro;
        *(u32x4*)(WT + (size_t)drow * ldt + k0 + 8 * c) = o;
    }
    LDS_WAIT(); asm volatile("" ::: "memory");
}
struct CvtSeg { const float* W; bf16* WT; int K, N, rs, ro; };
__device__ __forceinline__ void p0_convert(Frame& F, const Params& p) {
    unsigned char* ws = p.ws;
    LAS unsigned char* scr = F.lds + F.wave * 8192;
    const int gw = F.vcu * NWAVES + F.wave, NGW = F.G * NWAVES;
    constexpr int NSEG = 2 + 2 + 2 + 2 + 3 + 3;
    for (int sgi = 0; sgi < NSEG; ++sgi) {
        const float* W; bf16* WT; int K, N, rs = 128, ro = 0, reps = 1; size_t wstep = 0, tstep = 0;
        if (sgi < 2)       { W = p.in[1] + (size_t)sgi * D * DIN; WT = (bf16*)(ws + WS_WIN) + (size_t)sgi * DIN * D; K = D; N = DIN; }
        else if (sgi < 4)  { W = p.in[7] + (size_t)(sgi - 2) * SBW * D; WT = (bf16*)(ws + WS_WA) + (size_t)(sgi - 2) * D * SBW; K = SBW; N = D; }
        else if (sgi < 6)  { W = p.in[8] + (size_t)(sgi - 4) * SBW * D; WT = (bf16*)(ws + WS_WB) + (size_t)(sgi - 4) * D * SBW; K = SBW; N = D; }
        else if (sgi < 8)  { W = p.in[9] + (size_t)(sgi - 6) * D * D; WT = (bf16*)(ws + WS_WOUT) + (size_t)(sgi - 6) * D * D; K = D; N = D; }
        else if (sgi == 8) { W = p.in[12]; WT = (bf16*)(ws + WS_W13D); K = D; N = FF_D; rs = 256; ro = 0; }
        else if (sgi == 9) { W = p.in[13]; WT = (bf16*)(ws + WS_W13D); K = D; N = FF_D; rs = 256; ro = 128; }
        else if (sgi == 10){ W = p.in[14]; WT = (bf16*)(ws + WS_W2D); K = FF_D; N = D; }
        else if (sgi == 11){ W = p.in[16]; WT = (bf16*)(ws + WS_W13E); K = D; N = FF_E; rs = 256; ro = 0; reps = NE; wstep = (size_t)D * FF_E; tstep = (size_t)2 * FF_E * D; }
        else if (sgi == 12){ W = p.in[17]; WT = (bf16*)(ws + WS_W13E); K = D; N = FF_E; rs = 256; ro = 128; reps = NE; wstep = (size_t)D * FF_E; tstep = (size_t)2 * FF_E * D; }
        else               { W = p.in[18]; WT = (bf16*)(ws + WS_W2E); K = FF_E; N = D; reps = NE; wstep = (size_t)FF_E * D; tstep = (size_t)D * FF_E; }
        const int ntn = N / 64, ntk = K / 64, per = ntn * ntk, tot = per * reps;
        for (int it = gw; it < tot; it += NGW) {
            const int rep = it / per, r = it - rep * per, kt = r / ntn, nti = r - kt * ntn;
            cvt_tile(W + (size_t)rep * wstep, N, WT + (size_t)rep * tstep, K, kt * 64, nti * 64, rs, ro, scr, F.lane);
        }
    }
    { const f32x4* x = (const f32x4*)p.in[0]; u32x2* o = (u32x2*)(ws + WS_XB); const size_t n4 = (size_t)S * D / 4;
        for (size_t i = (size_t)blockIdx.x * NTHREADS + F.tid; i < n4; i += (size_t)F.G * NTHREADS) { const f32x4 v = x[i]; u32x2 w; w.x = cvt_pk_bf16(v[0], v[1]); w.y = cvt_pk_bf16(v[2], v[3]); o[i] = w; } }
}

namespace att {
#define KSWZ(row, colB) ((row) * 256 + ((colB) ^ (((row) & 7) << 4)))
__device__ __forceinline__ int crow(int r, int hi) { return (r & 3) + 8 * (r >> 2) + 4 * hi; }
__device__ __forceinline__ int v_st(int k, int c) { const int kk = (k & ~0xC) | ((k & 4) << 1) | ((k & 8) >> 1); return ((kk >> 3) * 4 + (c >> 5)) * 512 + ((kk & 7) * 32 + (c & 31)) * 2; }
__device__ __forceinline__ int v_rd_base(int lane) { return ((lane & 3) << 3) | (((lane >> 2) & 3) << 6) | (((lane >> 4) & 1) << 5) | (((lane >> 5) & 1) << 8); }
constexpr int v_rd_off(int d0, int ks, int half) { return d0 * 512 + ks * 4096 + half * 2048; }
template <int OFF> __device__ __forceinline__ s16x4 tr_read(int vb) {
    s16x4 r; asm volatile("ds_read_b64_tr_b16 %0, %1 offset:%2" : "=&v"(r) : "v"(vb), "i"(OFF) : "memory"); return r;
}
template <int D0> __device__ __forceinline__ void pv_one(f32x16& od, int vb, bf16x8 pa0, bf16x8 pa1, bf16x8 pa2, bf16x8 pa3) {
    const s16x4 l0 = tr_read<v_rd_off(D0, 0, 0)>(vb), h0 = tr_read<v_rd_off(D0, 0, 1)>(vb), l1 = tr_read<v_rd_off(D0, 1, 0)>(vb), h1 = tr_read<v_rd_off(D0, 1, 1)>(vb);
    const s16x4 l2 = tr_read<v_rd_off(D0, 2, 0)>(vb), h2 = tr_read<v_rd_off(D0, 2, 1)>(vb), l3 = tr_read<v_rd_off(D0, 3, 0)>(vb), h3 = tr_read<v_rd_off(D0, 3, 1)>(vb);
    asm volatile("s_waitcnt lgkmcnt(0)" ::: "memory"); SBAR();
#define PK(L, H) (bf16x8){L[0], L[1], L[2], L[3], H[0], H[1], H[2], H[3]}
    od = __builtin_amdgcn_mfma_f32_32x32x16_bf16(pa0, PK(l0, h0), od, 0, 0, 0);
    od = __builtin_amdgcn_mfma_f32_32x32x16_bf16(pa1, PK(l1, h1), od, 0, 0, 0);
    od = __builtin_amdgcn_mfma_f32_32x32x16_bf16(pa2, PK(l2, h2), od, 0, 0, 0);
    od = __builtin_amdgcn_mfma_f32_32x32x16_bf16(pa3, PK(l3, h3), od, 0, 0, 0);
#undef PK
}
__device__ __forceinline__ void qkt(f32x16& p0, f32x16& p1, const LAS unsigned char* Ks, const bf16x8* qr, int r32, int hi) {
    p0 = f32x16{}; p1 = f32x16{};
#pragma unroll
    for (int d0 = 0; d0 < 8; ++d0) { const int cb = (d0 * 16 + hi * 8) * 2;
        const bf16x8 b0 = *(const LAS bf16x8*)(Ks + KSWZ(r32, cb));
        const bf16x8 b1 = *(const LAS bf16x8*)(Ks + KSWZ(32 + r32, cb));
        p0 = __builtin_amdgcn_mfma_f32_32x32x16_bf16(b0, qr[d0], p0, 0, 0, 0);
        p1 = __builtin_amdgcn_mfma_f32_32x32x16_bf16(b1, qr[d0], p1, 0, 0, 0); }
}
__device__ __forceinline__ void stick_tile(f32x16& p0, f32x16& p1, float& Rm, int hi, bf16x8& pa0, bf16x8& pa1, bf16x8& pa2, bf16x8& pa3) {
    float I[8][4];
#pragma unroll
    for (int g = 0; g < 8; ++g) {
#pragma unroll
        for (int e = 3; e >= 0; --e) {
            const float z = (g < 4) ? p0[4 * g + e] : p1[4 * (g - 4) + e];
            const float sp = fast_log2(1.f + fast_exp2(fminf(z, 126.f)));
            I[g][e] = (e == 3) ? sp : I[g][e + 1] + sp;
        }
    }
    float IS[9];
    IS[8] = hi ? 0.f : Rm;
#pragma unroll
    for (int g = 7; g >= 0; --g) IS[g] = IS[g + 1] + I[g][0];
    float TB[8];
#pragma unroll
    for (int g = 0; g < 8; ++g) {
        const auto rr = __builtin_amdgcn_permlane32_swap(__float_as_uint(IS[g]), __float_as_uint(IS[g + 1]), false, false);
        const float sel = hi ? __uint_as_float(rr[0]) : __uint_as_float(rr[1]);
        TB[g] = IS[g + 1] + sel;
    }
    { const auto rr = __builtin_amdgcn_permlane32_swap(__float_as_uint(IS[0]), __float_as_uint(IS[0]), false, false);
      const float other = hi ? __uint_as_float(rr[0]) : __uint_as_float(rr[1]);
      Rm = IS[0] + other; }
#pragma unroll
    for (int g = 0; g < 8; ++g)
#pragma unroll
        for (int e = 0; e < 4; ++e) {
            const float z = (g < 4) ? p0[4 * g + e] : p1[4 * (g - 4) + e];
            const float a = fast_exp2(z - (TB[g] + I[g][e]));
            if (g < 4) p0[4 * g + e] = a; else p1[4 * (g - 4) + e] = a;
        }
#define PK4(P, BASE, OUT) do { unsigned a0 = cvt_pk_bf16(P[BASE + 0], P[BASE + 1]), a1 = cvt_pk_bf16(P[BASE + 2], P[BASE + 3]);   \
    unsigned b0 = cvt_pk_bf16(P[BASE + 4], P[BASE + 5]), b1 = cvt_pk_bf16(P[BASE + 6], P[BASE + 7]);                              \
    auto r0 = __builtin_amdgcn_permlane32_swap(a0, b0, false, false); auto r1 = __builtin_amdgcn_permlane32_swap(a1, b1, false, false); \
    u32x4 w = {r0[0], r1[0], r0[1], r1[1]}; OUT = __builtin_bit_cast(bf16x8, w); } while (0)
    PK4(p0, 0, pa0); PK4(p0, 8, pa1); PK4(p1, 0, pa2); PK4(p1, 8, pa3);
#undef PK4
}
constexpr int SHM_V = 16384, SHM_K = 16384;
__device__ __forceinline__ void attn_unit(const bf16* __restrict__ P, bf16* __restrict__ AO, int h, int qb, LAS unsigned char* lds, int tid, int wid, int lane) {
    const int r32 = lane & 31, hi = lane >> 5;
    LAS unsigned char* V_lds = lds; LAS unsigned char* K_lds = lds + 2 * SHM_V;
    const int t0 = qb * 256 + wid * 32;
    bf16x8 qr[8];
    { const bf16* Qw = P + (size_t)(t0 + r32) * DIN + OFF_Q + h * HD + hi * 8;
#pragma unroll
      for (int d0 = 0; d0 < 8; ++d0) qr[d0] = *(const bf16x8*)(Qw + d0 * 16); }
    const int sr = tid >> 4, sc = (tid & 15) * 8, vst0 = v_st(sr, sc), vst1 = v_st(32 + sr, sc);
    const int vb0 = (int)(unsigned)(uintptr_t)V_lds + v_rd_base(lane);
    const bf16* Kg = P + OFF_K + h * HD + sc; const bf16* Vg = P + OFF_V + h * HD + sc;
    bf16x8 vs0, vs1, ks0, ks1;
#define SLOAD(k0) do { vs0 = *(const bf16x8*)(Vg + (size_t)((k0) + sr) * DIN); vs1 = *(const bf16x8*)(Vg + (size_t)((k0) + 32 + sr) * DIN); \
    ks0 = *(const bf16x8*)(Kg + (size_t)((k0) + sr) * DIN); ks1 = *(const bf16x8*)(Kg + (size_t)((k0) + 32 + sr) * DIN); } while (0)
#define SWRITE(b) do { *(LAS bf16x8*)(V_lds + (b) * SHM_V + vst0) = vs0; *(LAS bf16x8*)(V_lds + (b) * SHM_V + vst1) = vs1; const int kc = sc * 2; \
    *(LAS bf16x8*)(K_lds + (b) * SHM_K + KSWZ(sr, kc)) = ks0; *(LAS bf16x8*)(K_lds + (b) * SHM_K + KSWZ(32 + sr, kc)) = ks1; } while (0)
    f32x16 o[4] = {};
    float Rm = 0.f; bool wdone = false;
    volatile LAS unsigned* flg = (volatile LAS unsigned*)(lds + 2 * SHM_V + 2 * SHM_K);
    const int jtop = 4 * qb + 3, jw = 4 * qb + (wid >> 1);
    SLOAD(jtop * 64); VM_WAIT(); SWRITE(0); __syncthreads();
    for (int j = jtop; j >= 0; --j) {
        const int buf = (jtop - j) & 1;
        if (j > 0) SLOAD((j - 1) * 64);
        if (j <= jw) {
            f32x16 p0, p1;
            qkt(p0, p1, K_lds + buf * SHM_K, qr, r32, hi);
            if (j == jw) {
                const int t = t0 + r32, kb = j * 64;
#pragma unroll
                for (int r = 0; r < 16; ++r) { if (kb + crow(r, hi) >= t) p0[r] = -1e30f; if (kb + 32 + crow(r, hi) >= t) p1[r] = -1e30f; }
            }
            bf16x8 pa0, pa1, pa2, pa3;
            stick_tile(p0, p1, Rm, hi, pa0, pa1, pa2, pa3);
            wdone = __all(Rm > 152.f);
            const int vb = vb0 + buf * SHM_V;
            pv_one<0>(o[0], vb, pa0, pa1, pa2, pa3); pv_one<1>(o[1], vb, pa0, pa1, pa2, pa3); pv_one<2>(o[2], vb, pa0, pa1, pa2, pa3); pv_one<3>(o[3], vb, pa0, pa1, pa2, pa3);
        }
        if (j > 0) { VM_WAIT(); SWRITE(buf ^ 1); }
        if (lane == 0) flg[(j & 1) * 8 + wid] = (j <= jw && wdone) ? 1u : 0u;
        __syncthreads();
        { unsigned all = 1u;
#pragma unroll
          for (int w = 0; w < NWAVES; ++w) all &= flg[(j & 1) * 8 + w];
          if (all) break; }
    }
    bf16* Ow = AO + (size_t)t0 * SBW + h * HD;
#pragma unroll
    for (int r = 0; r < 16; ++r) { const int orow = crow(r, hi);
#pragma unroll
        for (int d0 = 0; d0 < 4; ++d0) Ow[(size_t)orow * SBW + d0 * 32 + r32] = f2bf(o[d0][r]); }
#undef SLOAD
#undef SWRITE
}
__device__ __forceinline__ void sgu_unit(const bf16* __restrict__ P, bf16* __restrict__ SO, const float* __restrict__ sgw, const float* __restrict__ sgb, const float* __restrict__ lng, const float* __restrict__ lnb,
                                         int c, int g, LAS unsigned char* lds, int tid, int wid, int lane) {
    const int r32 = lane & 31, hi = lane >> 5;
    {
        const int s = tid >> 2, qd = tid & 3;
        const bf16* src = P + (size_t)(c * 128 + s) * DIN + OFF_VG + g * 128 + qd * 32;
        float x[32];
#pragma unroll
        for (int i = 0; i < 4; ++i) { const u32x4 w = *(const u32x4*)(src + 8 * i);
#pragma unroll
            for (int j = 0; j < 4; ++j) { x[8 * i + 2 * j] = __builtin_bit_cast(float, w[j] << 16); x[8 * i + 2 * j + 1] = __builtin_bit_cast(float, w[j] & 0xffff0000u); } }
        float sm = 0.f;
#pragma unroll
        for (int i = 0; i < 32; ++i) sm += x[i];
        sm += __shfl_xor(sm, 1); sm += __shfl_xor(sm, 2);
        const float mu = sm * (1.f / 128.f);
        float q = 0.f;
#pragma unroll
        for (int i = 0; i < 32; ++i) { x[i] -= mu; q += x[i] * x[i]; }
        q += __shfl_xor(q, 1); q += __shfl_xor(q, 2);
        const float rstd = rsqrtf(q * (1.f / 128.f) + LN_EPS);
        const float* gg = lng + g * 128 + qd * 32; const float* bb = lnb + g * 128 + qd * 32;
#pragma unroll
        for (int i = 0; i < 4; ++i) { u32x4 w;
#pragma unroll
            for (int j = 0; j < 4; ++j) { const int ch = 8 * i + 2 * j; w[j] = cvt_pk_bf16(x[ch] * rstd * gg[ch] + bb[ch], x[ch + 1] * rstd * gg[ch + 1] + bb[ch + 1]); }
            *(LAS u32x4*)(lds + (s >> 6) * SHM_V + v_st(s & 63, qd * 32 + 8 * i)) = w; }
    }
    __syncthreads();
    const int tb = wid >> 1, dh = wid & 1;
    f32x16 o[2] = {};
    const int vb0 = (int)(unsigned)(uintptr_t)lds + v_rd_base(lane);
    const int t = 32 * tb + r32;
    const float* wrow = sgw + ((size_t)g * 128 + t) * 128;
#pragma unroll
    for (int kt = 0; kt < 2; ++kt) {
        if (64 * kt <= 32 * tb + 31) {
            bf16x8 pa[4];
#pragma unroll
            for (int ks = 0; ks < 4; ++ks) { const int s0 = 64 * kt + 16 * ks + 8 * hi;
                const f32x4 w0 = *(const f32x4*)(wrow + s0), w1 = *(const f32x4*)(wrow + s0 + 4);
                u32x4 w; w.x = cvt_pk_bf16(s0 + 0 <= t ? w0[0] : 0.f, s0 + 1 <= t ? w0[1] : 0.f); w.y = cvt_pk_bf16(s0 + 2 <= t ? w0[2] : 0.f, s0 + 3 <= t ? w0[3] : 0.f);
                w.z = cvt_pk_bf16(s0 + 4 <= t ? w1[0] : 0.f, s0 + 5 <= t ? w1[1] : 0.f); w.w = cvt_pk_bf16(s0 + 6 <= t ? w1[2] : 0.f, s0 + 7 <= t ? w1[3] : 0.f);
                pa[ks] = __builtin_bit_cast(bf16x8, w); }
            const int vb = vb0 + kt * SHM_V;
            if (dh == 0) { pv_one<0>(o[0], vb, pa[0], pa[1], pa[2], pa[3]); pv_one<1>(o[1], vb, pa[0], pa[1], pa[2], pa[3]); }
            else         { pv_one<2>(o[0], vb, pa[0], pa[1], pa[2], pa[3]); pv_one<3>(o[1], vb, pa[0], pa[1], pa[2], pa[3]); }
        }
    }
#pragma unroll
    for (int r = 0; r < 16; ++r) { const int tt = 32 * tb + crow(r, hi); const float bt = sgb[g * 128 + tt]; const size_t row = (size_t)(c * 128 + tt);
#pragma unroll
        for (int i = 0; i < 2; ++i) { const int d = 64 * dh + 32 * i + r32;
            const float u = bf2f(P[row * DIN + OFF_U + g * 128 + d]);
            SO[row * SBW + g * 128 + d] = f2bf(u * (o[i][r] + bt)); } }
    __syncthreads();
}
}

template <int MODE, bool ROUTE>
__device__ __forceinline__ void ln_phase(Frame& F, const float* __restrict__ Y, const float* __restrict__ X1, const float* __restrict__ YS, const float* __restrict__ YS2, const int* __restrict__ tinfo, const float* __restrict__ tw,
                                         const float* __restrict__ g, const float* __restrict__ b, float* __restrict__ XF, bf16* __restrict__ XBo, const float* __restrict__ Wr, int* cnt, int* tinfo_o, float* tw_o, bf16* __restrict__ XG) {
    const int gw = F.vcu * NWAVES + F.wave, NGW = F.G * NWAVES, lane = F.lane;
    for (int row = gw; row < S; row += NGW) {
        f32x4 v[8];
        if (MODE == 1) {
            const int e0 = tinfo[row * 4 + 0], p0 = tinfo[row * 4 + 1], e1 = tinfo[row * 4 + 2], p1 = tinfo[row * 4 + 3];
            const int r0 = 256 * (int)F.MISC[16 + e0] + p0, r1 = 256 * (int)F.MISC[16 + e1] + p1;
            const int np = (int)F.MISC[16 + NE], rs = 256 * ((((np * (D / 256)) / F.G) * F.G) / (D / 256));
            const float w0 = tw[row * 2], w1 = tw[row * 2 + 1];
            const f32x4* x = (const f32x4*)(X1 + (size_t)row * D); const f32x4* y0 = (const f32x4*)(YS + (size_t)r0 * D); const f32x4* y1 = (const f32x4*)(YS + (size_t)r1 * D);
            f32x4 a0[8], a1[8];
#pragma unroll
            for (int j = 0; j < 8; ++j) { a0[j] = y0[lane + 64 * j]; a1[j] = y1[lane + 64 * j]; }
            if (r0 >= rs) {
#pragma unroll
                for (int q = 0; q < 3; ++q) { const f32x4* yq = (const f32x4*)(YS2 + ((size_t)q * 2048 + (r0 - rs)) * D);
#pragma unroll
                    for (int j = 0; j < 8; ++j) a0[j] = a0[j] + yq[lane + 64 * j]; } }
            if (r1 >= rs) {
#pragma unroll
                for (int q = 0; q < 3; ++q) { const f32x4* yq = (const f32x4*)(YS2 + ((size_t)q * 2048 + (r1 - rs)) * D);
#pragma unroll
                    for (int j = 0; j < 8; ++j) a1[j] = a1[j] + yq[lane + 64 * j]; } }
#pragma unroll
            for (int j = 0; j < 8; ++j) v[j] = x[lane + 64 * j] * ALPHA + (a0[j] * w0 + a1[j] * w1);
        } else {
            const f32x4* y = (const f32x4*)(Y + (size_t)row * D);
#pragma unroll
            for (int j = 0; j < 8; ++j) v[j] = y[lane + 64 * j];
        }
        float s = 0.f;
#pragma unroll
        for (int j = 0; j < 8; ++j) s += (v[j][0] + v[j][1]) + (v[j][2] + v[j][3]);
        const float mu = wave_sum(s) * (1.f / D);
        float q = 0.f;
#pragma unroll
        for (int j = 0; j < 8; ++j) { v[j] = v[j] - mu; q += (v[j][0] * v[j][0] + v[j][1] * v[j][1]) + (v[j][2] * v[j][2] + v[j][3] * v[j][3]); }
        const float rstd = rsqrtf(wave_sum(q) * (1.f / D) + LN_EPS);
#pragma unroll
        for (int j = 0; j < 8; ++j) { const f32x4 gg = ((const f32x4*)g)[lane + 64 * j], bb = ((const f32x4*)b)[lane + 64 * j];
            v[j] = v[j] * rstd * gg + bb;
            if (XF) ((f32x4*)(XF + (size_t)row * D))[lane + 64 * j] = v[j];
            if (XBo) { u32x2 w; w.x = cvt_pk_bf16(v[j][0], v[j][1]); w.y = cvt_pk_bf16(v[j][2], v[j][3]); ((u32x2*)(XBo + (size_t)row * D))[lane + 64 * j] = w; } }
        if (ROUTE) {
            float acc[NE];
#pragma unroll
            for (int e = 0; e < NE; ++e) acc[e] = 0.f;
#pragma unroll 2
            for (int j = 0; j < 8; ++j)
#pragma unroll
                for (int i = 0; i < 4; ++i) { const int d = 4 * (lane + 64 * j) + i; const float xv = v[j][i];
                    const f32x4 w0 = *(const f32x4*)(Wr + (size_t)d * NE), w1 = *(const f32x4*)(Wr + (size_t)d * NE + 4);
                    acc[0] = fmaf(xv, w0[0], acc[0]); acc[1] = fmaf(xv, w0[1], acc[1]); acc[2] = fmaf(xv, w0[2], acc[2]); acc[3] = fmaf(xv, w0[3], acc[3]);
                    acc[4] = fmaf(xv, w1[0], acc[4]); acc[5] = fmaf(xv, w1[1], acc[5]); acc[6] = fmaf(xv, w1[2], acc[6]); acc[7] = fmaf(xv, w1[3], acc[7]); }
#pragma unroll
            for (int e = 0; e < NE; ++e) acc[e] = wave_sum(acc[e]);
            int i0 = 0, i1 = 0, q0 = 0, q1 = 0;
            if (lane == 0) {
                float l0 = acc[0];
#pragma unroll
                for (int e = 1; e < NE; ++e) if (acc[e] > l0) { l0 = acc[e]; i0 = e; }
                i1 = -1; float l1 = -3.4e38f;
#pragma unroll
                for (int e = 0; e < NE; ++e) if (e != i0 && acc[e] > l1) { l1 = acc[e]; i1 = e; }
                const float e1 = expf(l1 - l0), w0 = 1.f / (1.f + e1), w1 = e1 / (1.f + e1);
                q0 = atomicAdd(&cnt[i0], 1); q1 = atomicAdd(&cnt[i1], 1);
                tinfo_o[row * 4 + 0] = i0; tinfo_o[row * 4 + 1] = q0; tinfo_o[row * 4 + 2] = i1; tinfo_o[row * 4 + 3] = q1;
                tw_o[row * 2] = w0; tw_o[row * 2 + 1] = w1;
            }
            i0 = __builtin_amdgcn_readfirstlane(i0); i1 = __builtin_amdgcn_readfirstlane(i1); q0 = __builtin_amdgcn_readfirstlane(q0); q1 = __builtin_amdgcn_readfirstlane(q1);
            u32x2* d0 = (u32x2*)(XG + ((size_t)i0 * S + q0) * D); u32x2* d1 = (u32x2*)(XG + ((size_t)i1 * S + q1) * D);
#pragma unroll
            for (int j = 0; j < 8; ++j) { u32x2 w; w.x = cvt_pk_bf16(v[j][0], v[j][1]); w.y = cvt_pk_bf16(v[j][2], v[j][3]); d0[lane + 64 * j] = w; d1[lane + 64 * j] = w; }
        }
    }
}
__device__ __forceinline__ void moe_table(Frame& F, const int* cnt) {
    if (F.tid == 0) { int acc = 0;
        for (int e = 0; e < NE; ++e) { F.MISC[16 + e] = (unsigned)acc; acc += (__hip_atomic_load(cnt + e, RLX_AGENT) + 255) / 256; }
        F.MISC[16 + NE] = (unsigned)acc; }
    __syncthreads();
}

constexpr int N_PHASES = 18;
#ifndef PH_ENABLE
#define PH_ENABLE 0x3FFFFu
#endif
#ifndef DUP_MASK
#define DUP_MASK 0u
#endif
__global__ void __launch_bounds__(NTHREADS, 2) mega(Params p) {
    extern __shared__ __attribute__((aligned(16))) unsigned char lds_raw[];
    Frame F;
    F.lds = (LAS unsigned char*)lds_raw;
    F.MISC = (volatile LAS unsigned*)(F.lds + MISC_OFF);
    F.tid = threadIdx.x; F.lane = F.tid & 63; F.wave = __builtin_amdgcn_readfirstlane(F.tid >> 6);
    F.G = gridDim.x; { const int bx = blockIdx.x; F.vcu = (F.G % 8 == 0) ? (bx % 8) * (F.G / 8) + bx / 8 : bx; }
    unsigned char* ws = p.ws;
    F.ctl = (gu32*)(ws + WS_CTL);
    for (int u = F.tid; u < (LDS_BYTES - LDSCTL_OFF) / 4; u += NTHREADS) ((LAS unsigned*)(F.lds + LDSCTL_OFF))[u] = 0u;
    __syncthreads();
    const int lo = p.ph_lo, hi = p.ph_hi;
    XcdBarrier bar; bar.bar = (unsigned*)(ws + WS_CTL) + CW_BAR + p.li * XCD_BAR_WORDS; bar.x = 0; bar.st = nullptr;
    if (hi - lo > 1) bar = xcd_barrier_post((unsigned*)(ws + WS_CTL) + CW_BAR + p.li * XCD_BAR_WORDS, F.MISC + 8);
#define IN(k) ((((unsigned)PH_ENABLE >> (k)) & 1u) && lo <= (k) && (k) < hi)
#define SEAM(k) do { if (IN(k) && IN((k) + 1)) xcd_barrier(bar); } while (0)
#define PHASE(k, ...) do { if (IN(k)) { __VA_ARGS__; } if ((((unsigned)DUP_MASK >> (k)) & 1u) && IN(k)) { __VA_ARGS__; } SEAM(k); } while (0)

    int* cnt = (int*)(ws + WS_CTL) + CW_CNT; int* tinfo = (int*)(ws + WS_TINFO); float* tw = (float*)(ws + WS_TW);
    bf16* XB = (bf16*)(ws + WS_XB); float* XC = (float*)(ws + WS_XC); float* X1 = (float*)(ws + WS_X1); bf16* X1B = (bf16*)(ws + WS_X1B);
    float* Y = (float*)(ws + WS_Y); bf16* XG = (bf16*)(ws + WS_XG); float* YS = (float*)(ws + WS_YS); float* YS2 = (float*)(ws + WS_YS2);
    bf16* P = (bf16*)(ws + WS_P); bf16* AO = (bf16*)(ws + WS_AO); bf16* SO = (bf16*)(ws + WS_SO); float* T = (float*)(ws + WS_T); bf16* MG = (bf16*)(ws + WS_MG);
    bf16* H = (bf16*)(ws + WS_H);
    const int bx = (int)blockIdx.x;

#define PH_INPROJ(layer) { \
        pg8::SchedPlain Sc; Sc.init(XB, D, (const bf16*)(ws + WS_WIN) + (size_t)(layer) * DIN * D, D, S, DIN, D, F.G, bx); \
        pg8::EpiProj E{P, p.in[2] + (layer) * 2 * D}; \
        pg8::gemm_phase<pg8::EpiProj, pg8::SchedPlain>(F.lds, D, D, Sc, E); }
#define PH_MIXER(layer) { \
        if (p.sub & 1) for (int u = F.vcu; u < NH * (S / 256); u += F.G) att::attn_unit(P, AO, u / (S / 256), u % (S / 256), F.lds, F.tid, F.wave, F.lane); \
        if (p.sub & 2) for (int u = F.vcu; u < (S / 128) * NG; u += F.G) \
            att::sgu_unit(P, SO, p.in[3] + (size_t)(layer) * NG * 128 * 128, p.in[4] + (layer) * NG * 128, p.in[5] + (layer) * SBW, p.in[6] + (layer) * SBW, u >> 3, u & 7, F.lds, F.tid, F.wave, F.lane); }
#define PH_BRANCH(layer) { \
        pg8::SchedTwoSeg Sc; Sc.init(AO, SO, SBW, (const bf16*)(ws + WS_WA) + (size_t)(layer) * D * SBW, (const bf16*)(ws + WS_WB) + (size_t)(layer) * D * SBW, SBW, S, D, SBW, F.G, bx); \
        pg8::EpiBranch E{T, MG, P}; \
        pg8::gemm_phase<pg8::EpiBranch, pg8::SchedTwoSeg>(F.lds, SBW, SBW, Sc, E); }
#define PH_OUTPROJ(layer) { \
        pg8::SchedPlain Sc; Sc.init(MG, D, (const bf16*)(ws + WS_WOUT) + (size_t)(layer) * D * D, D, S, D, D, F.G, bx); \
        pg8::EpiResid E{Y, (layer) == 0 ? p.in[0] : XC}; \
        pg8::gemm_phase<pg8::EpiResid, pg8::SchedPlain>(F.lds, D, D, Sc, E); }
#define PH_FFN_UP_D { \
        pg8::SchedPlain Sc; Sc.init(X1B, D, (const bf16*)(ws + WS_W13D), D, S, 2 * FF_D, D, F.G, bx); \
        pg8::EpiSwiGlu E{H, FF_D}; \
        pg8::gemm_phase<pg8::EpiSwiGlu, pg8::SchedPlain>(F.lds, D, D, Sc, E); }
#define PH_FFN_DOWN_D { \
        pg8::SchedPlain Sc; Sc.init(H, FF_D, (const bf16*)(ws + WS_W2D), FF_D, S, D, FF_D, F.G, bx); \
        pg8::EpiResid E{Y, X1}; \
        pg8::gemm_phase<pg8::EpiResid, pg8::SchedPlain>(F.lds, FF_D, FF_D, Sc, E); }
#define PH_MOE_UP { \
        moe_table(F, cnt); \
        pg8::SchedMoeUp Sc; Sc.init(XG, D, (const bf16*)(ws + WS_W13E), D, 2 * FF_E, D, (const volatile LAS int*)(F.MISC + 16), F.G, bx); \
        pg8::EpiSwiGlu E{H, FF_E}; \
        pg8::gemm_phase<pg8::EpiSwiGlu, pg8::SchedMoeUp>(F.lds, D, D, Sc, E); }
#define PH_MOE_DOWN { \
        moe_table(F, cnt); \
        pg8::SchedMoeDown Sc; Sc.init(H, FF_E, (const bf16*)(ws + WS_W2E), FF_E, D, FF_E, (const volatile LAS int*)(F.MISC + 16), F.G, bx); \
        pg8::EpiMoeDown E{YS, YS2, Sc.NF, 0}; \
        pg8::gemm_phase<pg8::EpiMoeDown, pg8::SchedMoeDown>(F.lds, FF_E, FF_E, Sc, E); }

    PHASE(0, p0_convert(F, p));
    PHASE(1, PH_INPROJ(0));
    PHASE(2, PH_MIXER(0));
    PHASE(3, PH_BRANCH(0));
    PHASE(4, PH_OUTPROJ(0));
    PHASE(5, (ln_phase<0, false>(F, Y, nullptr, nullptr, nullptr, nullptr, nullptr, p.in[10], p.in[11], X1, X1B, nullptr, nullptr, nullptr, nullptr, nullptr)));
    PHASE(6, PH_FFN_UP_D);
    PHASE(7, PH_FFN_DOWN_D);
    PHASE(8, (ln_phase<0, false>(F, Y, nullptr, nullptr, nullptr, nullptr, nullptr, p.in[19], p.in[20], XC, XB, nullptr, nullptr, nullptr, nullptr, nullptr)));
    PHASE(9, PH_INPROJ(1));
    PHASE(10, PH_MIXER(1));
    PHASE(11, PH_BRANCH(1));
    PHASE(12, PH_OUTPROJ(1));
    PHASE(13, (ln_phase<0, true>(F, Y, nullptr, nullptr, nullptr, nullptr, nullptr, p.in[10] + D, p.in[11] + D, X1, nullptr, p.in[15], cnt, tinfo, tw, XG)));
    PHASE(15, PH_MOE_UP);
    PHASE(16, PH_MOE_DOWN);
    PHASE(17, { moe_table(F, cnt); ln_phase<1, false>(F, nullptr, X1, YS, YS2, tinfo, tw, p.in[19] + D, p.in[20] + D, p.out, nullptr, nullptr, nullptr, nullptr, nullptr, nullptr); });
#undef IN
#undef SEAM
#undef PHASE
}
}

#ifndef NEW_MASK
#define NEW_MASK 0x3FFFFu
#endif
#ifndef NEW_ATT
#define NEW_ATT 1
#endif
#ifndef NEW_SGU
#define NEW_SGU 1
#endif
#ifndef FUSE
#define FUSE 1
#endif
extern "C" void kernel_launch(void* const* d_in, const int* in_sizes, int n_in, void* d_out, int out_size, void* d_ws, size_t ws_size, hipStream_t stream) {
    static int grid = 0;
    if (grid == 0) {
        if (n_in != 21 || ws_size < WS_END2) { fprintf(stderr, "kernel_launch: unexpected n_in %d / ws %zu (need %zu)\n", n_in, ws_size, (size_t)WS_END2); grid = -1; return; }
        int dev = 0, cus = 0, per_cu = 0;
        if (hipGetDevice(&dev) != hipSuccess || hipDeviceGetAttribute(&cus, hipDeviceAttributeMultiprocessorCount, dev) != hipSuccess) { grid = -1; return; }
        if (hipFuncSetAttribute((const void*)mk::mega, hipFuncAttributeMaxDynamicSharedMemorySize, mk::LDS_BYTES) != hipSuccess) { fprintf(stderr, "kernel_launch: hipFuncSetAttribute failed\n"); grid = -1; return; }
        if (hipOccupancyMaxActiveBlocksPerMultiprocessor(&per_cu, (const void*)mk::mega, mk::NTHREADS, mk::LDS_BYTES) != hipSuccess || per_cu < 1) { fprintf(stderr, "kernel_launch: occupancy query says %d\n", per_cu); }
        (void)hipGetLastError();
        grid = cus;
    }
    if (grid < 0) return;
    char* ws = (char*)d_ws;
    (void)hipMemsetAsync(ws + WS_CTL, 0, CTL_ZERO_BYTES, stream);
    mk::Params prm{};
    for (int i = 0; i < 21; ++i) prm.in[i] = (const float*)d_in[i];
    prm.out = (float*)d_out; prm.ws = (unsigned char*)d_ws; prm.sub = (NEW_ATT ? 1 : 0) | (NEW_SGU ? 2 : 0);
    const unsigned mask = NEW_MASK;
#if NEW_MASK != 0x3FFFFu || !NEW_ATT || !NEW_SGU
    const float* x_in = (const float*)d_in[0];
    const float* w_in = (const float*)d_in[1];   const float* b_gate = (const float*)d_in[2];
    const float* sg_w = (const float*)d_in[3];   const float* sg_b = (const float*)d_in[4];
    const float* sg_ln_g = (const float*)d_in[5]; const float* sg_ln_b = (const float*)d_in[6];
    const float* w_a = (const float*)d_in[7];    const float* w_b = (const float*)d_in[8];   const float* w_out = (const float*)d_in[9];
    const float* ln1_g = (const float*)d_in[10]; const float* ln1_b = (const float*)d_in[11];
    const float* ffn_w1 = (const float*)d_in[12]; const float* ffn_w3 = (const float*)d_in[13]; const float* ffn_w2 = (const float*)d_in[14];
    const float* moe_router = (const float*)d_in[15];
    const float* moe_w1 = (const float*)d_in[16]; const float* moe_w3 = (const float*)d_in[17]; const float* moe_w2 = (const float*)d_in[18];
    const float* ln2_g = (const float*)d_in[19]; const float* ln2_b = (const float*)d_in[20];
    float* out = (float*)d_out;
    int* cnt = (int*)(ws + WS_CTL) + CW_CNT; int* tinfo = (int*)(ws + WS_TINFO); float* tw = (float*)(ws + WS_TW);
    bf16* XB = (bf16*)(ws + WS_XB); float* XC = (float*)(ws + WS_XC); float* X1 = (float*)(ws + WS_X1); bf16* X1B = (bf16*)(ws + WS_X1B);
    float* Y = (float*)(ws + WS_Y); bf16* XG = (bf16*)(ws + WS_XG); float* YS = (float*)(ws + WS_YS);
    bf16* P = (bf16*)(ws + WS_P); bf16* AO = (bf16*)(ws + WS_AO); bf16* SO = (bf16*)(ws + WS_SO); float* T = (float*)(ws + WS_T); bf16* MG = (bf16*)(ws + WS_MG);
    bf16* H = (bf16*)(ws + WS_H); float* LNV = T;
    const dim3 blk(256);
#endif
    int li = 0;
    for (int ph = 0; ph < mk::N_PHASES;) {
        if (mask & (1u << ph)) {
            int hi = ph + 1;
            if (FUSE) while (hi < mk::N_PHASES && (mask & (1u << hi)) && !(((hi - 1) == 2 || (hi - 1) == 10) && !(NEW_ATT && NEW_SGU))) ++hi;
            prm.ph_lo = ph; prm.ph_hi = hi; prm.li = li++;
            hipLaunchKernelGGL(mk::mega, dim3(grid), dim3(mk::NTHREADS), mk::LDS_BYTES, stream, prm);
#if NEW_MASK != 0x3FFFFu || !NEW_ATT || !NEW_SGU
            if (ph <= 2 && 2 < hi) { if (!NEW_ATT) hipLaunchKernelGGL(nv::attn, dim3(S * NH / 4), blk, 0, stream, P, AO);
                if (!NEW_SGU) { hipLaunchKernelGGL(nv::sgu_ln, dim3(S * NG / 4), blk, 0, stream, P, sg_ln_g, sg_ln_b, LNV); hipLaunchKernelGGL(nv::sgu_mix, dim3(64 * NG), blk, 0, stream, P, LNV, sg_w, sg_b, SO); } }
            if (ph <= 10 && 10 < hi) { if (!NEW_ATT) hipLaunchKernelGGL(nv::attn, dim3(S * NH / 4), blk, 0, stream, P, AO);
                if (!NEW_SGU) { hipLaunchKernelGGL(nv::sgu_ln, dim3(S * NG / 4), blk, 0, stream, P, sg_ln_g + SBW, sg_ln_b + SBW, LNV); hipLaunchKernelGGL(nv::sgu_mix, dim3(64 * NG), blk, 0, stream, P, LNV, sg_w + (size_t)NG * 128 * 128, sg_b + NG * 128, SO); } }
#endif
            ph = hi; continue;
        }
#if NEW_MASK != 0x3FFFFu || !NEW_ATT || !NEW_SGU
        const int layer = ph >= 9 ? 1 : 0; const int k = ph == 0 ? -1 : (ph - 1) % 8 + (ph >= 14 ? 8 : 0);
        const float* xres = layer == 0 ? x_in : XC;
        if (ph == 0) hipLaunchKernelGGL(nv::cvt_bf16, dim3(2048), blk, 0, stream, x_in, XB, (size_t)S * D / 4);
        else if (ph == 1 || ph == 9) hipLaunchKernelGGL((nv::gemm<bf16, nv::EpiProj, false>), dim3(DIN / 64, S / 64), blk, 0, stream, XB, nullptr, w_in + (size_t)layer * D * DIN, nullptr, D, 0, DIN, S, DIN, D, nv::EpiProj{P, b_gate + layer * 2 * D});
        else if (ph == 2 || ph == 10) { hipLaunchKernelGGL(nv::attn, dim3(S * NH / 4), blk, 0, stream, P, AO);
            hipLaunchKernelGGL(nv::sgu_ln, dim3(S * NG / 4), blk, 0, stream, P, sg_ln_g + layer * SBW, sg_ln_b + layer * SBW, LNV);
            hipLaunchKernelGGL(nv::sgu_mix, dim3(64 * NG), blk, 0, stream, P, LNV, sg_w + (size_t)layer * NG * 128 * 128, sg_b + layer * NG * 128, SO); }
        else if (ph == 3 || ph == 11) { hipLaunchKernelGGL((nv::gemm<bf16, nv::EpiGateA, false>), dim3(D / 64, S / 64), blk, 0, stream, AO, nullptr, w_a + (size_t)layer * SBW * D, nullptr, SBW, 0, D, S, D, SBW, nv::EpiGateA{T, P});
            hipLaunchKernelGGL((nv::gemm<bf16, nv::EpiGateB, false>), dim3(D / 64, S / 64), blk, 0, stream, SO, nullptr, w_b + (size_t)layer * SBW * D, nullptr, SBW, 0, D, S, D, SBW, nv::EpiGateB{T, P, MG}); }
        else if (ph == 4 || ph == 12) hipLaunchKernelGGL((nv::gemm<bf16, nv::EpiResid, false>), dim3(D / 64, S / 64), blk, 0, stream, MG, nullptr, w_out + (size_t)layer * D * D, nullptr, D, 0, D, S, D, D, nv::EpiResid{Y, xres});
        else if (ph == 5) hipLaunchKernelGGL(nv::ln_rows, dim3(S / 4), blk, 0, stream, Y, nullptr, nullptr, nullptr, nullptr, nullptr, ln1_g, ln1_b, X1, X1B);
        else if (ph == 6) hipLaunchKernelGGL((nv::gemm<bf16, nv::EpiSwiGlu, true>), dim3(FF_D / 64, S / 64), blk, 0, stream, X1B, nullptr, ffn_w1, ffn_w3, D, 0, FF_D, S, FF_D, D, nv::EpiSwiGlu{H, FF_D});
        else if (ph == 7) hipLaunchKernelGGL((nv::gemm<bf16, nv::EpiResid, false>), dim3(D / 64, S / 64), blk, 0, stream, H, nullptr, ffn_w2, nullptr, FF_D, 0, D, S, D, FF_D, nv::EpiResid{Y, X1});
        else if (ph == 8) hipLaunchKernelGGL(nv::ln_rows, dim3(S / 4), blk, 0, stream, Y, nullptr, nullptr, nullptr, nullptr, nullptr, ln2_g, ln2_b, XC, XB);
        else if (ph == 13) { hipLaunchKernelGGL(nv::ln_rows, dim3(S / 4), blk, 0, stream, Y, nullptr, nullptr, nullptr, nullptr, nullptr, ln1_g + D, ln1_b + D, X1, X1B);
            hipLaunchKernelGGL(nv::moe_route, dim3(S / 4), blk, 0, stream, X1, moe_router, cnt, tinfo, tw); }
        else if (ph == 14) hipLaunchKernelGGL(nv::moe_gather, dim3(S * 2 / 4), blk, 0, stream, X1B, tinfo, cnt, XG);
        else if (ph == 15) { for (int e = 0; e < NE; ++e) hipLaunchKernelGGL((nv::gemm<bf16, nv::EpiSwiGlu, true>), dim3(FF_E / 64, S / 64), blk, 0, stream, XG, cnt, moe_w1 + (size_t)e * D * FF_E, moe_w3 + (size_t)e * D * FF_E, D, e, FF_E, S, FF_E, D, nv::EpiSwiGlu{H, FF_E}); }
        else if (ph == 16) { for (int e = 0; e < NE; ++e) hipLaunchKernelGGL((nv::gemm<bf16, nv::EpiStoreF, false>), dim3(D / 64, S / 64), blk, 0, stream, H, cnt, moe_w2 + (size_t)e * FF_E * D, nullptr, FF_E, e, D, S, D, FF_E, nv::EpiStoreF{YS, D}); }
        else if (ph == 17) hipLaunchKernelGGL(nv::ln_rows, dim3(S / 4), blk, 0, stream, nullptr, X1, YS, tinfo, tw, cnt, ln2_g + D, ln2_b + D, out, nullptr);
        (void)k;
#endif
        ++ph;
    }
}
```
